# Optimizing an MI355X kernel written in HIP

```python
import math
import jax, jax.numpy as jnp
from jax import lax
import numpy as np

D_MODEL = 1024
BATCH = 8
SEQ = 4096
DEPTH = 1

GRID_W = 64
CTX_LEN = 256
MLA_HEADS = 8
MLA_NOPE = 64
MLA_ROPE = 32
MLA_QK = MLA_NOPE + MLA_ROPE
MLA_V = 64
Q_LORA = 256
KV_LORA = 128
MLA_W = MLA_HEADS * MLA_V
MLA_SCALE = MLA_QK ** -0.5
ROPE_THETA = 10000.0
Q_BLOCK = 128
NA_HEADS = 8
NA_DIM = 64
NA_W = NA_HEADS * NA_DIM
NA_WIN_H = 8
NA_WIN_W = 16
NA_SCALE = NA_DIM ** -0.5
D_IN = Q_LORA + KV_LORA + MLA_ROPE + 3 * NA_W + 2 * D_MODEL
N_EXPERTS = 16
D_EXPERT = 1024
EC_CAPACITY = 2
LN_EPS = 1e-5
RMS_EPS = 1e-6
ALPHA = (2.0 * DEPTH) ** 0.25
BETA = (8.0 * DEPTH) ** -0.25

kernel_name = 'hybrid_mla_natten_ec_dit_block'


def _layer_norm(x, g=None, b=None):
    xf = x.astype(jnp.float32)
    mu = jnp.mean(xf, axis=-1, keepdims=True)
    var = jnp.mean(jnp.square(xf - mu), axis=-1, keepdims=True)
    y = (xf - mu) * lax.rsqrt(var + LN_EPS)
    if g is not None:
        y = y * g.astype(jnp.float32) + b.astype(jnp.float32)
    return y.astype(x.dtype)


def _rms_norm(x, g):
    xf = x.astype(jnp.float32)
    y = xf * lax.rsqrt(jnp.mean(jnp.square(xf), axis=-1, keepdims=True) + RMS_EPS)
    return (y * g.astype(jnp.float32)).astype(x.dtype)


def _axial_rope_tables(n):
    t = jnp.arange(n, dtype=jnp.int32)
    row = (t // GRID_W).astype(jnp.float32)
    col = (t % GRID_W).astype(jnp.float32)
    per_axis = MLA_ROPE // 2
    inv_freq = ROPE_THETA ** (-jnp.arange(0, per_axis, 2, dtype=jnp.float32) / per_axis)
    ang = jnp.concatenate([row[:, None] * inv_freq, col[:, None] * inv_freq], axis=-1)
    return jnp.cos(ang), jnp.sin(ang)


def _rope(x, cos, sin):
    half = x.shape[-1] // 2
    x1 = x[..., :half].astype(jnp.float32)
    x2 = x[..., half:].astype(jnp.float32)
    return jnp.concatenate([x1 * cos - x2 * sin, x1 * sin + x2 * cos], axis=-1).astype(x.dtype)


def _modulation(cvec, w_mod, b_mod):
    m = jax.nn.silu(cvec) @ w_mod + b_mod
    return jnp.split(m, 6, axis=-1)


def _split_in(p):
    o1 = Q_LORA
    o2 = o1 + KV_LORA
    o3 = o2 + MLA_ROPE
    o4 = o3 + 3 * NA_W
    return p[..., :o1], p[..., o1:o2], p[..., o2:o3], p[..., o3:o4], p[..., o4:]


def _mla_q(q_c, q_norm_g, w_uq, rope):
    B, n = q_c.shape[:2]
    q = (_rms_norm(q_c, q_norm_g) @ w_uq).reshape(B, n, MLA_HEADS, MLA_QK)
    q_nope, q_rope = q[..., :MLA_NOPE], q[..., MLA_NOPE:]
    if rope is not None:
        cos, sin = rope
        q_rope = _rope(q_rope, cos[:, None], sin[:, None])
    return jnp.concatenate([q_nope, q_rope], axis=-1)


def _mla_kv(kv_c, k_r, kv_norm_g, w_ukv, rope):
    B, n = kv_c.shape[:2]
    kv = (_rms_norm(kv_c, kv_norm_g) @ w_ukv).reshape(B, n, MLA_HEADS, MLA_NOPE + MLA_V)
    k_nope, v = kv[..., :MLA_NOPE], kv[..., MLA_NOPE:]
    if rope is not None:
        cos, sin = rope
        k_r = _rope(k_r, cos, sin)
    k_rope = jnp.broadcast_to(k_r[:, :, None, :], (B, n, MLA_HEADS, MLA_ROPE))
    return jnp.concatenate([k_nope, k_rope], axis=-1), v


def _na_split(na):
    B, n = na.shape[:2]
    qkv = na.reshape(B, n, 3, NA_HEADS, NA_DIM)
    return qkv[:, :, 0], qkv[:, :, 1], qkv[:, :, 2]


def _attend(q, k, v, scale):
    s = jnp.einsum('bqhd,bkhd->bhqk', q, k).astype(jnp.float32) * scale
    p = jax.nn.softmax(s, axis=-1).astype(v.dtype)
    return jnp.einsum('bhqk,bkhd->bqhd', p, v)


def _mla_latent(q, k_all, v_all):
    B, n, H, dq = q.shape
    nb = n // Q_BLOCK
    qb = q.reshape(B, nb, Q_BLOCK, H, dq).transpose(1, 0, 2, 3, 4)
    out = lax.map(lambda qi: _attend(qi, k_all, v_all, MLA_SCALE), qb)
    return out.transpose(1, 0, 2, 3, 4).reshape(B, n, H * MLA_V)


def _natten_latent(q, k, v, k_ctx, v_ctx, rel_bias):
    B, n, H, d = q.shape
    rows = n // GRID_W
    wh = min(NA_WIN_H, rows)
    ww = NA_WIN_W
    qg = q.reshape(B, rows, GRID_W, H, d)
    kg = k.reshape(B, rows, GRID_W, H, d)
    vg = v.reshape(B, rows, GRID_W, H, d)
    col = np.arange(GRID_W)
    col_start = np.clip(col - ww // 2, 0, GRID_W - ww)
    col_idx = col_start[:, None] + np.arange(ww)[None, :]
    dc = col_idx - col[:, None] + (NA_WIN_W - 1)
    nk = wh * ww

    def row_fn(r):
        r0 = jnp.clip(r - wh // 2, 0, rows - wh)
        q_r = lax.dynamic_index_in_dim(qg, r, axis=1, keepdims=False)
        k_band = lax.dynamic_slice_in_dim(kg, r0, wh, axis=1)
        v_band = lax.dynamic_slice_in_dim(vg, r0, wh, axis=1)
        k_win = k_band[:, :, col_idx].transpose(0, 2, 1, 3, 4, 5).reshape(B, GRID_W, nk, H, d)
        v_win = v_band[:, :, col_idx].transpose(0, 2, 1, 3, 4, 5).reshape(B, GRID_W, nk, H, d)
        dr = r0 + jnp.arange(wh) - r + (NA_WIN_H - 1)
        bias = rel_bias[:, dr[:, None, None], dc[None]]
        bias = bias.transpose(0, 2, 1, 3).reshape(H, GRID_W, nk)
        s_loc = jnp.einsum('bqhd,bqkhd->bhqk', q_r, k_win).astype(jnp.float32) * NA_SCALE + bias[None].astype(jnp.float32)
        s_ctx = jnp.einsum('bqhd,bkhd->bhqk', q_r, k_ctx).astype(jnp.float32) * NA_SCALE
        p = jax.nn.softmax(jnp.concatenate([s_loc, s_ctx], axis=-1), axis=-1).astype(v.dtype)
        return (jnp.einsum('bhqk,bqkhd->bqhd', p[..., :nk], v_win)
                + jnp.einsum('bhqk,bkhd->bqhd', p[..., nk:], v_ctx))

    out = lax.map(row_fn, jnp.arange(rows, dtype=jnp.int32))
    return out.transpose(1, 0, 2, 3, 4).reshape(B, n, H * d)


def _merge(y_mla, y_na, gates, w_proj_mla, w_proj_na, w_out):
    g_mla, g_na = jnp.split(gates, 2, axis=-1)
    return (jax.nn.sigmoid(g_mla) * (y_mla @ w_proj_mla) + jax.nn.sigmoid(g_na) * (y_na @ w_proj_na)) @ w_out


def _expert_choice_ffn(u, w_router, w_exp_gate, w_exp_up, w_exp_down):
    B, n, D = u.shape
    cap = EC_CAPACITY * n // N_EXPERTS
    aff = jax.nn.softmax((u @ w_router).astype(jnp.float32), axis=-1)
    g, idx = lax.top_k(aff.transpose(0, 2, 1), cap)
    xe = jax.vmap(lambda ub, ib: ub[ib])(u, idx)
    h = jax.nn.silu(jnp.einsum('becd,edf->becf', xe, w_exp_gate)) * jnp.einsum('becd,edf->becf', xe, w_exp_up)
    ye = jnp.einsum('becf,efd->becd', h, w_exp_down) * g[..., None].astype(u.dtype)
    return jax.vmap(lambda yb, ib: jnp.zeros((n, D), yb.dtype).at[ib.reshape(-1)].add(yb.reshape(-1, D)))(ye, idx)


def _layer(x, ctx, c, c_ctx, lp, rope, update_ctx):
    B, n, _ = x.shape
    L = ctx.shape[1]
    sh1, sc1, g1, sh2, sc2, g2 = [m[:, None, :] for m in _modulation(c, lp['w_mod'], lp['b_mod'])]
    csh1, csc1, cg1, csh2, csc2, cg2 = _modulation(c_ctx, lp['w_mod'], lp['b_mod'])

    u = _layer_norm(x) * (1 + sc1) + sh1
    uc = _layer_norm(ctx) * (1 + csc1) + csh1
    q_c, kv_c, k_r, na, gates = _split_in(u @ lp['w_in'])
    cq_c, ckv_c, ck_r, cna, cgates = _split_in(uc @ lp['w_in'])

    mq = _mla_q(q_c, lp['q_norm_g'], lp['w_uq'], rope)
    mk, mv = _mla_kv(kv_c, k_r, lp['kv_norm_g'], lp['w_ukv'], rope)
    cmk, cmv = _mla_kv(ckv_c, ck_r, lp['kv_norm_g'], lp['w_ukv'], None)
    y_mla = _mla_latent(mq, jnp.concatenate([cmk, mk], axis=1), jnp.concatenate([cmv, mv], axis=1))

    nq, nk, nv = _na_split(na)
    cnq, cnk, cnv = _na_split(cna)
    y_na = _natten_latent(nq, nk, nv, cnk, cnv, lp['na_rel_bias'])

    mix = _merge(y_mla, y_na, gates, lp['w_proj_mla'], lp['w_proj_na'], lp['w_out'])
    x_new = _layer_norm(ALPHA * x + g1 * mix, lp['ln1_g'], lp['ln1_b'])

    u2 = _layer_norm(x_new) * (1 + sc2) + sh2
    moe = _expert_choice_ffn(u2, lp['w_router'], lp['w_exp_gate'], lp['w_exp_up'], lp['w_exp_down'])
    x_new = _layer_norm(ALPHA * x_new + g2 * moe, lp['ln2_g'], lp['ln2_b'])

    if update_ctx:
        cmq = _mla_q(cq_c, lp['q_norm_g'], lp['w_uq'], None)
        yc_mla = _attend(cmq, cmk, cmv, MLA_SCALE).reshape(B, L, MLA_W)
        yc_na = _attend(cnq, cnk, cnv, NA_SCALE).reshape(B, L, NA_W)
        cmix = _merge(yc_mla, yc_na, cgates, lp['w_proj_mla'], lp['w_proj_na'], lp['w_out'])
        ctx = _layer_norm(ALPHA * ctx + cg1 * cmix, lp['ln1_g'], lp['ln1_b'])
        uc2 = _layer_norm(ctx) * (1 + csc2) + csh2
        cmoe = _expert_choice_ffn(uc2, lp['w_router'], lp['w_exp_gate'], lp['w_exp_up'], lp['w_exp_down'])
        ctx = _layer_norm(ALPHA * ctx + cg2 * cmoe, lp['ln2_g'], lp['ln2_b'])
    return x_new, ctx


def setup_inputs(seed: int = 0) -> dict:
    key = jax.random.key(seed)
    ks = jax.random.split(key, 26)

    def nrm(k, shape, scale):
        return jax.random.normal(k, shape, jnp.float32) * scale

    Ld = DEPTH
    return {
        'x': nrm(ks[0], (BATCH, SEQ, D_MODEL), 1.0),
        'c': nrm(ks[1], (BATCH, D_MODEL), 1.0),
        'ctx': nrm(ks[2], (BATCH, CTX_LEN, D_MODEL), 1.0),
        'c_ctx': nrm(ks[3], (D_MODEL,), 1.0),
        'w_mod': nrm(ks[4], (Ld, D_MODEL, 6 * D_MODEL), 0.5 * D_MODEL ** -0.5),
        'b_mod': nrm(ks[5], (Ld, 6 * D_MODEL), 0.02),
        'w_in': nrm(ks[6], (Ld, D_MODEL, D_IN), D_MODEL ** -0.5),
        'q_norm_g': 1.0 + nrm(ks[7], (Ld, Q_LORA), 0.02),
        'w_uq': nrm(ks[8], (Ld, Q_LORA, MLA_HEADS * MLA_QK), Q_LORA ** -0.5),
        'kv_norm_g': 1.0 + nrm(ks[9], (Ld, KV_LORA), 0.02),
        'w_ukv': nrm(ks[10], (Ld, KV_LORA, MLA_HEADS * (MLA_NOPE + MLA_V)), KV_LORA ** -0.5),
        'na_rel_bias': nrm(ks[11], (Ld, NA_HEADS, 2 * NA_WIN_H - 1, 2 * NA_WIN_W - 1), 0.1),
        'w_proj_mla': nrm(ks[12], (Ld, MLA_W, D_MODEL), MLA_W ** -0.5),
        'w_proj_na': nrm(ks[13], (Ld, NA_W, D_MODEL), NA_W ** -0.5),
        'w_out': nrm(ks[14], (Ld, D_MODEL, D_MODEL), BETA * D_MODEL ** -0.5),
        'ln1_g': 1.0 + nrm(ks[15], (Ld, D_MODEL), 0.02),
        'ln1_b': nrm(ks[16], (Ld, D_MODEL), 0.02),
        'w_router': nrm(ks[17], (Ld, D_MODEL, N_EXPERTS), D_MODEL ** -0.5),
        'w_exp_gate': nrm(ks[18], (Ld, N_EXPERTS, D_MODEL, D_EXPERT), D_MODEL ** -0.5),
        'w_exp_up': nrm(ks[19], (Ld, N_EXPERTS, D_MODEL, D_EXPERT), D_MODEL ** -0.5),
        'w_exp_down': nrm(ks[20], (Ld, N_EXPERTS, D_EXPERT, D_MODEL), BETA * D_EXPERT ** -0.5),
        'ln2_g': 1.0 + nrm(ks[21], (Ld, D_MODEL), 0.02),
        'ln2_b': nrm(ks[22], (Ld, D_MODEL), 0.02),
    }


def reference(x, c, ctx, c_ctx, w_mod, b_mod, w_in, q_norm_g, w_uq, kv_norm_g, w_ukv, na_rel_bias,
              w_proj_mla, w_proj_na, w_out, ln1_g, ln1_b, w_router, w_exp_gate, w_exp_up, w_exp_down,
              ln2_g, ln2_b):
    n = x.shape[1]
    rope = _axial_rope_tables(n)
    for l in range(DEPTH):
        lp = dict(w_mod=w_mod[l], b_mod=b_mod[l], w_in=w_in[l], q_norm_g=q_norm_g[l], w_uq=w_uq[l],
                  kv_norm_g=kv_norm_g[l], w_ukv=w_ukv[l], na_rel_bias=na_rel_bias[l],
                  w_proj_mla=w_proj_mla[l], w_proj_na=w_proj_na[l], w_out=w_out[l],
                  ln1_g=ln1_g[l], ln1_b=ln1_b[l], w_router=w_router[l], w_exp_gate=w_exp_gate[l],
                  w_exp_up=w_exp_up[l], w_exp_down=w_exp_down[l], ln2_g=ln2_g[l], ln2_b=ln2_b[l])
        x, ctx = _layer(x, ctx, c, c_ctx, lp, rope, update_ctx=(l < DEPTH - 1))
    return x
```

```cpp
#include <hip/hip_runtime.h>
#include <hip/hip_bf16.h>
#include <hip/hip_cooperative_groups.h>
#include <cstdio>
#include <cstdint>
#include <cmath>

#ifndef MK_N_LAUNCHES
#define MK_N_LAUNCHES 1
#endif
#ifndef MK_PHASE_MASK
#define MK_PHASE_MASK 0x3FFF
#endif
#ifndef MK_REPEAT
#define MK_REPEAT 0
#endif
#ifndef MK_DEBUG
#define MK_DEBUG 0
#endif

#define LAS __attribute__((address_space(3)))
#define GAS __attribute__((address_space(1)))
typedef unsigned short bf16_t;
typedef short bf16x8 __attribute__((ext_vector_type(8)));
typedef short s16x4 __attribute__((ext_vector_type(4)));
typedef float f32x4 __attribute__((ext_vector_type(4)));
typedef float f32x2 __attribute__((ext_vector_type(2)));
typedef float f32x16 __attribute__((ext_vector_type(16)));
typedef unsigned u32x4 __attribute__((ext_vector_type(4)));
typedef unsigned u32x2 __attribute__((ext_vector_type(2)));
typedef _Float16 h16x2 __attribute__((ext_vector_type(2)));
typedef __bf16 bf16x2_t __attribute__((ext_vector_type(2)));

constexpr int DM = 1024, NBATCH = 8, SEQ = 4096, CTXL = 256, SCOMB = SEQ + CTXL;
constexpr int MX = NBATCH * SEQ;
constexpr int MC = NBATCH * SCOMB;
constexpr int NEXP = 16, CAP = 512, ME = NBATCH * NEXP * CAP;
constexpr int D_IN = 4000;
constexpr float LOG2E = 1.4426950408889634f;
constexpr float MLA_QS = 0.10206207261596575f * LOG2E;
constexpr float NA_QS = 0.125f * LOG2E;
constexpr float ALPHA = 1.189207115002721f;
constexpr float LN_EPS = 1e-5f, RMS_EPS = 1e-6f;

__device__ __forceinline__ unsigned cvtpk(float lo, float hi) { f32x2 v = {lo, hi}; bf16x2_t b = __builtin_convertvector(v, bf16x2_t); return __builtin_bit_cast(unsigned, b); }
__device__ __forceinline__ float bf2f(unsigned short h) { return __uint_as_float((unsigned)h << 16); }
__device__ __forceinline__ float bflo(unsigned w) { return __uint_as_float(w << 16); }
__device__ __forceinline__ float bfhi(unsigned w) { return __uint_as_float(w & 0xffff0000u); }

namespace pg8 {
constexpr int BM = 256, BK = 64, HALF = 128, HTB = HALF * BK * 2, STAGE_BYTES = 8 * HTB;
__host__ __device__ __forceinline__ int lds_byte(int r, int c) { const int st = (r >> 4) * 2 + (c >> 5), rr = r & 15, cc = c & 31, ob = rr * 64 + cc * 2; return st * 1024 + (ob ^ (((ob >> 9) & 1) << 5)); }
__host__ __device__ __forceinline__ void stage_rc(int b, int& R, int& C) { const int st = b / 1024, sb = b % 1024, swz = sb ^ (((sb >> 9) & 1) << 5); R = (st >> 1) * 16 + swz / 64; C = (st & 1) * 32 + (swz % 64) / 2; }
__host__ __device__ __forceinline__ int perm32(int rho) { const int n = rho >> 4, i = rho & 15; return 8 * (i >> 2) + 4 * n + (i & 3); }

struct Unit { int pm, pn, pb; };

template <class Epi, class Sched, bool ALIGN_EPI, bool GATHER = false>
__device__ __forceinline__ void gemm_phase(LAS unsigned char* lds, const bf16_t* Ag, const bf16_t* Btg, const int K, const Sched& S, const Epi& E, const int* gidx = nullptr) {
    const int tid = threadIdx.x, wid = __builtin_amdgcn_readfirstlane(tid >> 6), lane = tid & 63, wr = wid >> 2, wc = wid & 3, fr = lane & 15, fq = lane >> 4;
    const int nt = K / BK;
    unsigned voffA[2], voffB[2];
#pragma unroll
    for (int i = 0; i < 2; ++i) { int R, C; stage_rc(tid * 16 + i * 8192, R, C); const int Rb = Epi::PERM ? ((R & ~31) + perm32(R & 31)) : R;
        voffA[i] = (unsigned)(R * K + C) * 2u; voffB[i] = (unsigned)(Rb * K + C) * 2u; }
    const size_t kstep = (size_t)(BK * 2);
    const size_t hstep = (size_t)HALF * K * 2;
    const size_t tstep = 2 * hstep;
    const unsigned ldsw = (unsigned)wid * 1024u;
    const int aoff = lds_byte(wr * 64 + fr, fq * 8), boff = lds_byte(wc * 32 + fr, fq * 8);
#define PG8_SA(b, h) (((b) * 2 + (h)) * HTB)
#define PG8_SB(b, h) ((4 + (b) * 2 + (h)) * HTB)
#define PG8_STAGE(bufoff, gbase, voff) do { _Pragma("unroll") for (int _i = 0; _i < 2; ++_i) \
        __builtin_amdgcn_global_load_lds((const unsigned*)((const char*)(gbase) + (voff)[_i]), (LAS unsigned*)(lds + (bufoff) + ldsw + _i * 8192), 16, 0, 0); } while (0)
#define PG8_LDA(dst, b, h) do { _Pragma("unroll") for (int m = 0; m < 4; ++m) _Pragma("unroll") for (int k = 0; k < 2; ++k) dst[m][k] = *(const LAS bf16x8*)(lds + PG8_SA(b, h) + aoff + m * 2048 + k * 1024); } while (0)
#define PG8_LDB(dst, b, h) do { _Pragma("unroll") for (int n = 0; n < 2; ++n) _Pragma("unroll") for (int k = 0; k < 2; ++k) dst[n][k] = *(const LAS bf16x8*)(lds + PG8_SB(b, h) + boff + n * 2048 + k * 1024); } while (0)
#define PG8_MMA(ai, bj, At, Bt) do { __builtin_amdgcn_s_setprio(1); _Pragma("unroll") for (int m = 0; m < 4; ++m) _Pragma("unroll") for (int n = 0; n < 2; ++n) _Pragma("unroll") for (int k = 0; k < 2; ++k) \
        acc[ai][bj][m][n] = __builtin_amdgcn_mfma_f32_16x16x32_bf16(Bt[n][k], At[m][k], acc[ai][bj][m][n], 0, 0, 0); __builtin_amdgcn_s_setprio(0); } while (0)
#define PG8_WAIT_V(n) asm volatile("s_waitcnt vmcnt(" #n ")" ::: "memory")
#define PG8_WAIT_L(n) asm volatile("s_waitcnt lgkmcnt(" #n ")" ::: "memory")
#define PG8_BAR __builtin_amdgcn_s_barrier()
#define PG8_SCHED __builtin_amdgcn_sched_barrier(0)
    Unit cur, nxt; int ui = 0;
    if (!S.next(0, cur)) return;
    unsigned gc[2][2], gn[2][2], g2[2][2];
#define PG8_GLOAD(g, u) do { _Pragma("unroll") for (int _i = 0; _i < 2; ++_i) { int R_, C_; stage_rc(tid * 16 + _i * 8192, R_, C_); _Pragma("unroll") for (int _h = 0; _h < 2; ++_h) \
        g[_h][_i] = (unsigned)gidx[(u).pm * 256 + _h * 128 + R_] * (unsigned)(K * 2) + (unsigned)(C_ * 2); } } while (0)
    if constexpr (GATHER) { PG8_GLOAD(gc, cur); }
    f32x4 acc[2][2][4][2];
#pragma unroll
    for (int a = 0; a < 2; ++a)
#pragma unroll
        for (int b = 0; b < 2; ++b)
#pragma unroll
            for (int m = 0; m < 4; ++m)
#pragma unroll
                for (int n = 0; n < 2; ++n) acc[a][b][m][n] = (f32x4){0.f, 0.f, 0.f, 0.f};
    bf16x8 At[4][2], B0[2][2], B1[2][2]; float pre[8];
    const char* cA = (const char*)Ag + (size_t)cur.pm * tstep; const char* cB = (const char*)Btg + (size_t)cur.pb * tstep;
    PG8_STAGE(PG8_SB(0, 0), cB, voffB); PG8_STAGE(PG8_SB(0, 1), cB + hstep, voffB);
    if constexpr (GATHER) { PG8_STAGE(PG8_SA(0, 0), Ag, gc[0]); PG8_STAGE(PG8_SA(0, 1), Ag, gc[1]); } else { PG8_STAGE(PG8_SA(0, 0), cA, voffA); PG8_STAGE(PG8_SA(0, 1), cA + hstep, voffA); }
    if (wr == 1) PG8_BAR;
    PG8_WAIT_V(2); PG8_BAR;
    PG8_STAGE(PG8_SB(1, 0), cB + kstep, voffB);
    if constexpr (GATHER) PG8_STAGE(PG8_SA(1, 0), (const char*)Ag + kstep, gc[0]); else PG8_STAGE(PG8_SA(1, 0), cA + kstep, voffA);
    PG8_STAGE(PG8_SB(1, 1), cB + hstep + kstep, voffB);
    PG8_WAIT_V(6); PG8_BAR;
    for (;;) {
        const bool has_next = S.next(ui + 1, nxt);
        const char* nA = has_next ? (const char*)Ag + (size_t)nxt.pm * tstep : cA; const char* nB = has_next ? (const char*)Btg + (size_t)nxt.pb * tstep : cB;
        if constexpr (GATHER) { if (has_next) { PG8_GLOAD(gn, nxt); } else { _Pragma("unroll") for (int _h = 0; _h < 2; ++_h) _Pragma("unroll") for (int _i = 0; _i < 2; ++_i) gn[_h][_i] = gc[_h][_i]; } }
#pragma unroll 1
        for (int t = 0; t < nt; t += 2) {
            if constexpr (Epi::HAS_MID) { if (t == (nt >> 1)) E.mid(acc, cur, wr, wc, fr, fq); }
            if constexpr (Epi::HAS_PRE) { if (t == nt - 4) E.pre_issue(pre, cur, wr, wc, fr, fq); if (t == nt - 2) E.pre_wait(pre); }
            const bool last = (t == nt - 2);
            const char* a1 = cA + (size_t)(t + 1) * kstep;
            const char* a2 = last ? nA : cA + (size_t)(t + 2) * kstep; const char* b2 = last ? nB : cB + (size_t)(t + 2) * kstep;
            const char* a3 = a2 + kstep; const char* b3 = b2 + kstep;
            const char* ka1 = (const char*)Ag + (size_t)(t + 1) * kstep; const char* ka2 = last ? (const char*)Ag : (const char*)Ag + (size_t)(t + 2) * kstep; const char* ka3 = ka2 + kstep;
            if constexpr (GATHER) { _Pragma("unroll") for (int _h = 0; _h < 2; ++_h) _Pragma("unroll") for (int _i = 0; _i < 2; ++_i) g2[_h][_i] = last ? gn[_h][_i] : gc[_h][_i]; }
#define PG8_STAGE_A(buf, h, apt, kapt, goff) do { if constexpr (GATHER) PG8_STAGE(PG8_SA(buf, h), kapt, goff[h]); else PG8_STAGE(PG8_SA(buf, h), (apt) + (h) * hstep, voffA); } while (0)
            PG8_LDB(B0, 0, 0); PG8_LDB(B1, 0, 1); PG8_SCHED; PG8_LDA(At, 0, 0); PG8_STAGE_A(1, 1, a1, ka1, gc);
            PG8_WAIT_V(8); PG8_WAIT_L(0); PG8_BAR; PG8_MMA(0, 0, At, B0); PG8_MMA(0, 1, At, B1); PG8_BAR; PG8_SCHED;
            PG8_LDA(At, 0, 1); PG8_STAGE(PG8_SB(0, 0), b2, voffB); PG8_STAGE(PG8_SB(0, 1), b2 + hstep, voffB); PG8_STAGE_A(0, 0, a2, ka2, g2);
            PG8_WAIT_V(8); PG8_WAIT_L(0); PG8_BAR; PG8_MMA(1, 0, At, B0); PG8_MMA(1, 1, At, B1); PG8_BAR; PG8_SCHED;
            PG8_LDB(B0, 1, 0); PG8_LDB(B1, 1, 1); PG8_SCHED; PG8_LDA(At, 1, 0); PG8_STAGE_A(0, 1, a2, ka2, g2);
            PG8_WAIT_V(8); PG8_WAIT_L(0); PG8_BAR; PG8_MMA(0, 0, At, B0); PG8_MMA(0, 1, At, B1); PG8_BAR; PG8_SCHED;
            PG8_LDA(At, 1, 1); PG8_STAGE(PG8_SB(1, 0), b3, voffB); PG8_STAGE(PG8_SB(1, 1), b3 + hstep, voffB); PG8_STAGE_A(1, 0, a3, ka3, g2);
            PG8_WAIT_V(8); PG8_WAIT_L(0); PG8_BAR; PG8_MMA(1, 0, At, B0); PG8_MMA(1, 1, At, B1); PG8_BAR; PG8_SCHED;
        }
        if constexpr (ALIGN_EPI) { if (wr == 0) PG8_BAR; }
        if constexpr (Epi::HAS_PRE) E.run(acc, cur, wr, wc, fr, fq, pre); else E(acc, cur, wr, wc, fr, fq);
        if (!has_next) break;
#pragma unroll
        for (int a = 0; a < 2; ++a)
#pragma unroll
            for (int b = 0; b < 2; ++b)
#pragma unroll
                for (int m = 0; m < 4; ++m)
#pragma unroll
                    for (int n = 0; n < 2; ++n) acc[a][b][m][n] = (f32x4){0.f, 0.f, 0.f, 0.f};
        cur = nxt; cA = nA; cB = nB; ++ui;
        if constexpr (GATHER) { _Pragma("unroll") for (int _h = 0; _h < 2; ++_h) _Pragma("unroll") for (int _i = 0; _i < 2; ++_i) gc[_h][_i] = gn[_h][_i]; }
        if constexpr (ALIGN_EPI) { if (wr == 1) PG8_BAR; }
    }
    PG8_WAIT_V(0);
    if constexpr (!ALIGN_EPI) { if (wr == 0) PG8_BAR; }
    PG8_BAR;
#undef PG8_SA
#undef PG8_SB
#undef PG8_STAGE
#undef PG8_LDA
#undef PG8_LDB
#undef PG8_MMA
#undef PG8_WAIT_V
#undef PG8_WAIT_L
#undef PG8_BAR
#undef PG8_SCHED
#undef PG8_GLOAD
#undef PG8_STAGE_A
}
}
using pg8::Unit;

constexpr size_t MiB = 1u << 20;
constexpr size_t WS_CTL = 0, CTL_ZERO_BYTES = 1 * MiB;
constexpr size_t WS_ZROW = 896 * 1024;
constexpr size_t WS_SSQ = 512 * 1024;
constexpr size_t WS_MOD = 1 * MiB;
constexpr size_t WS_ROPE = 1 * MiB + 256 * 1024;
constexpr size_t WS_GV = 1 * MiB + 512 * 1024;
constexpr size_t WS_IDX = 1 * MiB + 768 * 1024;
constexpr size_t WS_WIN = 2 * MiB;
constexpr size_t WS_WUQ = 10 * MiB;
constexpr size_t WS_WUKV = 10 * MiB + 512 * 1024;
constexpr size_t WS_WPROJ = 11 * MiB;
constexpr size_t WS_WOUT = 13 * MiB;
constexpr size_t WS_WGU = 16 * MiB;
constexpr size_t WS_WD = 80 * MiB;
constexpr size_t WS_A = 112 * MiB, WS_B = 240 * MiB, WS_C = 368 * MiB, WS_END = 512 * MiB;
constexpr size_t WS_GATES = WS_A;
constexpr size_t WS_XE = WS_A;
constexpr size_t WS_YE = WS_A;
constexpr size_t WS_U = WS_B;
constexpr size_t WS_QM = WS_B;
constexpr size_t WS_KMN = WS_B + 48 * MiB;
constexpr size_t WS_VM = WS_B + 82 * MiB;
constexpr size_t WS_MIXR = WS_C;
constexpr size_t WS_H = WS_B;
constexpr size_t WS_QC = WS_C;
constexpr size_t WS_KVX = WS_C + 16 * MiB;
constexpr size_t WS_NQ = WS_C + 33 * MiB;
constexpr size_t WS_NK = WS_C + 65 * MiB;
constexpr size_t WS_NV = WS_C + 99 * MiB;
constexpr size_t WS_AFF = WS_C + 133 * MiB;
constexpr size_t WS_INV = WS_C + 135 * MiB;
constexpr size_t WS_T = WS_B;
constexpr size_t WS_U2 = WS_C + 64 * MiB;
static_assert(WS_NV + (size_t)MC * 512 * 2 <= WS_AFF && WS_INV + (size_t)MX * 16 * 4 <= WS_END && WS_VM + (size_t)MC * 512 * 2 <= WS_C && WS_KMN + (size_t)MC * 512 * 2 <= WS_VM, "ws map");
static_assert(WS_U2 + (size_t)MX * 1024 * 2 <= WS_AFF && WS_QM + (size_t)MX * 768 * 2 <= WS_KMN && WS_KVX + (size_t)MC * 256 * 2 <= WS_NQ && WS_NQ + (size_t)MX * 512 * 2 <= WS_NK && WS_NK + (size_t)MC * 512 * 2 <= WS_NV, "ws map 2");
constexpr int CW_MODFLAG = 2048;
constexpr int CW_BAR = 4096;

constexpr int RING_OFF = 0, RING_BYTES = 131072;
constexpr int LDSCTL_OFF = RING_BYTES, MISC_OFF = LDSCTL_OFF + 320;
constexpr int LDS_BYTES = 147456;
constexpr int NWAVES = 8;

typedef GAS unsigned gu32;
#define RLX_AGENT __ATOMIC_RELAXED, __HIP_MEMORY_SCOPE_AGENT
#define LDS_WAIT() asm volatile("s_waitcnt lgkmcnt(0)" ::: "memory")
#define VM_WAIT() asm volatile("s_waitcnt vmcnt(0)" ::: "memory")

#define XB_TMO      128
#define XB_XCNT(j)  (256  + 64 * (j))
#define XB_XSUB(j)  (1280 + 64 * (j))
#define XB_XGEN(j)  (2304 + 64 * (j))
#define XB_TOP      3328
#define XB_TOPGEN   3392
#define XCD_BAR_WORDS 3456
#define XB_SPIN_CAP (1u << 20)
__device__ __forceinline__ unsigned xb_ld(unsigned* p)              { return __hip_atomic_load(p, __ATOMIC_RELAXED, __HIP_MEMORY_SCOPE_AGENT); }
__device__ __forceinline__ unsigned xb_add(unsigned* p, unsigned v) { return __hip_atomic_fetch_add(p, v, __ATOMIC_RELAXED, __HIP_MEMORY_SCOPE_AGENT); }
__device__ __forceinline__ unsigned xb_xcc_id() { return (unsigned)__builtin_amdgcn_s_getreg((3 << 11) | 20) & 0xFu; }
#define XB_SPIN(cond, bar) do { unsigned _sp = 0; while (cond) { __builtin_amdgcn_s_sleep(1); \
    if ((++_sp & 255u) == 0u) { if (xb_ld(&(bar)[XB_TMO])) break; if (_sp > XB_SPIN_CAP) { atomicAdd(&(bar)[XB_TMO], 1u); break; } } } } while (0)
struct XcdBarrier { unsigned* bar; unsigned x; volatile LAS unsigned* st; };
__device__ __forceinline__ XcdBarrier xcd_barrier_post(unsigned* bar, volatile LAS unsigned* st) {
    XcdBarrier b; b.bar = bar; b.x = xb_xcc_id(); b.st = st;
    if (threadIdx.x == 0) (void)xb_add(&bar[XB_XCNT(b.x)], 1u);
    return b;
}
__device__ __forceinline__ void xcd_barrier_complete(unsigned* bar, unsigned x, unsigned& nloc, unsigned& nx) {
    const unsigned G = gridDim.x * gridDim.y * gridDim.z;
    unsigned sum, cnt, mine, sp = 0u;
    for (;;) {
        sum = 0u; cnt = 0u; mine = 0u;
#pragma unroll
        for (unsigned j = 0; j < 16; ++j) { const unsigned c = xb_ld(&bar[XB_XCNT(j)]); sum += c; cnt += (c > 0u) ? 1u : 0u; mine = (j == x) ? c : mine; }
        if (sum == G) break;
        __builtin_amdgcn_s_sleep(1);
        if ((++sp & 255u) == 0u) { if (xb_ld(&bar[XB_TMO])) break; if (sp > XB_SPIN_CAP) { atomicAdd(&bar[XB_TMO], 1u); break; } }
    }
    nloc = mine > 0u ? mine : 1u; nx = cnt > 0u ? cnt : 1u;
}
__device__ __forceinline__ void xcd_barrier(const XcdBarrier& b) {
    asm volatile("s_waitcnt vmcnt(0)" ::: "memory");
    __syncthreads();
    if (threadIdx.x == 0) {
        unsigned* bar = b.bar;
        __builtin_amdgcn_s_waitcnt(0);
        unsigned nloc = b.st[0], nx = b.st[1];
        if (nloc == 0u) { xcd_barrier_complete(bar, b.x, nloc, nx); b.st[0] = nloc; b.st[1] = nx; }
        const unsigned old = xb_add(&bar[XB_XSUB(b.x)], 1u);
        const unsigned gen = old / nloc;
        if (old + 1u == (gen + 1u) * nloc) {
            __builtin_amdgcn_fence(__ATOMIC_RELEASE, "agent");
            asm volatile("s_waitcnt vmcnt(0)" ::: "memory");
            const unsigned og = xb_add(&bar[XB_TOP], 1u);
            const unsigned tg = og / nx;
            if (og + 1u == (tg + 1u) * nx) xb_add(&bar[XB_TOPGEN], 1u);
            else XB_SPIN(xb_ld(&bar[XB_TOPGEN]) == tg, bar);
            __builtin_amdgcn_fence(__ATOMIC_ACQUIRE, "agent");
            xb_add(&bar[XB_XGEN(b.x)], 1u);
            asm volatile("s_waitcnt vmcnt(0)" ::: "memory");
        } else {
            XB_SPIN(xb_ld(&bar[XB_XGEN(b.x)]) == gen, bar);
            __builtin_amdgcn_fence(__ATOMIC_ACQUIRE, "agent");
            asm volatile("s_waitcnt vmcnt(0)" ::: "memory");
        }
    }
    __syncthreads();
}

struct Frame {
    LAS unsigned char* lds;
    volatile LAS unsigned* MISC;
    int tid, lane, wave;
    int vcu, G;
    unsigned char* ws;
    const float* in[23];
    float* out;
};
template <int CTRL> __device__ __forceinline__ float dppf(float v) { return __int_as_float(__builtin_amdgcn_update_dpp(0, __float_as_int(v), CTRL, 0xf, 0xf, true)); }
__device__ __forceinline__ float rlane(float v, int l) { return __int_as_float(__builtin_amdgcn_readlane(__float_as_int(v), l)); }
#define DPP_XOR1 0xB1
#define DPP_XOR2 0x4E
#define DPP_QREV 0x1B
#define DPP_HMIR 0x141
#define DPP_RMIR 0x140
#define DPP_ROR8 0x128
__device__ __forceinline__ float lane_xor4(float v) { return dppf<DPP_HMIR>(dppf<DPP_QREV>(v)); }
__device__ __forceinline__ float wave_sum_q(float v) {
    v += dppf<DPP_HMIR>(v); v += dppf<DPP_RMIR>(v);
    return (rlane(v, 0) + rlane(v, 16)) + (rlane(v, 32) + rlane(v, 48));
}
__device__ __forceinline__ float wave_max_q(float v) {
    v = fmaxf(v, dppf<DPP_HMIR>(v)); v = fmaxf(v, dppf<DPP_RMIR>(v));
    return fmaxf(fmaxf(rlane(v, 0), rlane(v, 16)), fmaxf(rlane(v, 32), rlane(v, 48)));
}
__device__ __forceinline__ float wave_sum(float v) { v += dppf<DPP_XOR1>(v); v += dppf<DPP_XOR2>(v); return wave_sum_q(v); }

struct SchedInProj {
    int G, c;
    __device__ __forceinline__ bool next(int i, Unit& u) const {
        const int L = i * G + c;
        constexpr int nM = 128, nN = 16, nwg = nM * nN;
        if (L < nwg) {
            int wgid = L; { const int q = nwg / 8, xcd = wgid % 8, off = wgid / 8; wgid = xcd * q + off; }
            const int nig = 8 * nN, gid = wgid / nig, fm = gid * 8;
            const int xpm = fm + ((wgid % nig) % 8); u.pn = (wgid % nig) / 8;
            u.pm = (xpm >> 4) * 17 + 1 + (xpm & 15); u.pb = u.pn; return true;
        }
        const int Lc = L - nwg; if (Lc >= 40) return false;
        u.pm = (Lc / 5) * 17; u.pn = Lc % 5; u.pb = u.pn; return true;
    }
};
struct SchedDense {
    int nM, nN, G, c;
    __device__ __forceinline__ bool next(int i, Unit& u) const {
        const int nwg = nM * nN; const long L = (long)i * G + c; if (L >= nwg) return false;
        int wgid = (int)L; { const int q = nwg / 8, r = nwg % 8, xcd = wgid % 8, off = wgid / 8; wgid = (xcd < r ? xcd * (q + 1) : r * (q + 1) + (xcd - r) * q) + off; }
        const int nig = 8 * nN, gid = wgid / nig, fm = gid * 8, gsz = (nM - fm) < 8 ? (nM - fm) : 8;
        u.pm = fm + ((wgid % nig) % gsz); u.pn = (wgid % nig) / gsz; u.pb = u.pn; return true;
    }
};
template <int NT> struct SchedExpert {
    int vcu;
    __device__ __forceinline__ bool next(int i, Unit& u) const {
        constexpr int RPE = NT / 4 * 2;
        if (i >= 2 * RPE) return false;
        const int xcd = vcu >> 5, w = vcu & 31, e = 2 * xcd + i / RPE, s = i % RPE;
        const int rt = 8 * (s / (NT / 4)) + (w & 7), ct = 4 * (s % (NT / 4)) + (w >> 3);
        u.pm = e * 16 + rt; u.pn = ct; u.pb = e * NT + ct; return true;
    }
};

__device__ __forceinline__ int opaque(int v) { asm volatile("" : "+v"(v)); return v; }
__device__ __forceinline__ u32x4 pack8(const f32x4 a, const f32x4 b) { u32x4 w; w.x = cvtpk(a[0], a[1]); w.y = cvtpk(a[2], a[3]); w.z = cvtpk(b[0], b[1]); w.w = cvtpk(b[2], b[3]); return w; }
__device__ __forceinline__ float sigmoidf_(float v) { return __builtin_amdgcn_rcpf(1.f + __builtin_amdgcn_exp2f(-v * LOG2E)); }
__device__ __forceinline__ float sumsq8(const f32x4 a, const f32x4 b) { return (a[0] * a[0] + a[1] * a[1]) + (a[2] * a[2] + a[3] * a[3]) + (b[0] * b[0] + b[1] * b[1]) + (b[2] * b[2] + b[3] * b[3]); }
__device__ __forceinline__ void rope8(f32x4& a, f32x4& b, const f32x4 cs, const f32x4 sn) {
    const f32x4 a0 = a, b0 = b;
    a[0] = a0[0] * cs[0] - a0[1] * sn[0]; a[1] = a0[0] * sn[0] + a0[1] * cs[0];
    a[2] = a0[2] * cs[1] - a0[3] * sn[1]; a[3] = a0[2] * sn[1] + a0[3] * cs[1];
    b[0] = b0[0] * cs[2] - b0[1] * sn[2]; b[1] = b0[0] * sn[2] + b0[1] * cs[2];
    b[2] = b0[2] * cs[3] - b0[3] * sn[3]; b[3] = b0[2] * sn[3] + b0[3] * cs[3];
}

struct EpiInProj {
    static constexpr bool PERM = true, HAS_MID = false, HAS_PRE = false;
    bf16_t *KVX, *NK, *NV, *QC, *NQ, *GATES; float *ssq_kv, *ssq_q; const float* rope; float ssc;
    __device__ __forceinline__ void operator()(const f32x4 (&acc)[2][2][4][2], const Unit& u, int wr, int wc, int fr_, int fq) const {
        const int fr = opaque(fr_);
        const int b = u.pm / 17, jt = u.pm % 17, pn = u.pn;
        const int col8 = wc * 32 + 8 * fq;
#pragma unroll
        for (int ai = 0; ai < 2; ++ai)
#pragma unroll
            for (int m = 0; m < 4; ++m) {
                const int rl = ai * 128 + wr * 64 + m * 16 + fr;
                const size_t mrow = (size_t)u.pm * 256 + rl;
                const size_t xrow = (size_t)(b * 16 + jt - 1) * 256 + rl;
                if (pn == 0) {
                    f32x4 v0 = acc[ai][0][m][0], v1 = acc[ai][0][m][1];
                    *(u32x4*)(KVX + mrow * 256 + col8) = pack8(v0, v1);
                    float ss = sumsq8(v0, v1); ss += __shfl_xor(ss, 16); ss += __shfl_xor(ss, 32);
                    if (fq == 0) atomicAdd(ssq_kv + mrow, ss * ssc);
                    f32x4 w0 = acc[ai][1][m][0], w1 = acc[ai][1][m][1];
                    if (wc == 0) {
                        if (jt > 0) { const int t = (jt - 1) * 256 + rl, p = (fq < 2) ? (t >> 6) : (t & 63), f0 = (fq & 1) * 4;
                            const f32x4 cs = *(const f32x4*)(rope + p * 8 + f0), sn = *(const f32x4*)(rope + 512 + p * 8 + f0); rope8(w0, w1, cs, sn); }
                    } else { w0 = (f32x4){0.f, 0.f, 0.f, 0.f}; w1 = w0; }
                    *(u32x4*)(KVX + mrow * 256 + 128 + col8) = pack8(w0, w1);
                } else if (pn <= 4) {
                    bf16_t* dst = (pn <= 2 ? NK : NV) + mrow * 512 + ((pn - 1) & 1) * 256 + col8;
#pragma unroll
                    for (int bj = 0; bj < 2; ++bj) *(u32x4*)(dst + bj * 128) = pack8(acc[ai][bj][m][0], acc[ai][bj][m][1]);
                } else if (pn == 5) {
                    float ss = 0.f;
#pragma unroll
                    for (int bj = 0; bj < 2; ++bj) { *(u32x4*)(QC + xrow * 256 + bj * 128 + col8) = pack8(acc[ai][bj][m][0], acc[ai][bj][m][1]); ss += sumsq8(acc[ai][bj][m][0], acc[ai][bj][m][1]); }
                    ss += __shfl_xor(ss, 16); ss += __shfl_xor(ss, 32);
                    if (fq == 0) atomicAdd(ssq_q + xrow, ss * ssc);
                } else if (pn <= 7) {
#pragma unroll
                    for (int bj = 0; bj < 2; ++bj) *(u32x4*)(NQ + xrow * 512 + (pn - 6) * 256 + bj * 128 + col8) = pack8(acc[ai][bj][m][0] * NA_QS, acc[ai][bj][m][1] * NA_QS);
                } else {
                    f32x4 a0 = acc[ai][0][m][0], a1 = acc[ai][0][m][1], n0 = acc[ai][1][m][0], n1 = acc[ai][1][m][1];
#pragma unroll
                    for (int k = 0; k < 4; ++k) {
                        const float dn0 = 1.f + __builtin_amdgcn_exp2f(-n0[k] * LOG2E), dn1 = 1.f + __builtin_amdgcn_exp2f(-n1[k] * LOG2E);
                        const float dm0 = 1.f + __builtin_amdgcn_exp2f(-a0[k] * LOG2E), dm1 = 1.f + __builtin_amdgcn_exp2f(-a1[k] * LOG2E);
                        n0[k] = __builtin_amdgcn_rcpf(dn0); n1[k] = __builtin_amdgcn_rcpf(dn1); a0[k] = dn0 * __builtin_amdgcn_rcpf(dm0); a1[k] = dn1 * __builtin_amdgcn_rcpf(dm1); }
                    *(u32x4*)(GATES + xrow * 2048 + (pn - 8) * 128 + col8) = pack8(a0, a1);
                    *(u32x4*)(GATES + xrow * 2048 + 1024 + (pn - 8) * 128 + col8) = pack8(n0, n1);
                }
            }
    }
};
struct EpiQUp {
    static constexpr bool PERM = true, HAS_MID = false, HAS_PRE = false;
    bf16_t* QM; const float* ssq_q; const float* rope;
    __device__ __forceinline__ void operator()(const f32x4 (&acc)[2][2][4][2], const Unit& u, int wr, int wc, int fr_, int fq) const {
        const int fr = opaque(fr_);
        float rs8[8];
#pragma unroll
        for (int i = 0; i < 8; ++i) rs8[i] = ssq_q[(size_t)u.pm * 256 + (i >> 2) * 128 + wr * 64 + (i & 3) * 16 + fr];
        int f0[2]; bool isr[2], hi8[2];
#pragma unroll
        for (int bj = 0; bj < 2; ++bj) { const int c0 = u.pn * 256 + bj * 128 + wc * 32 + 8 * fq, d0 = c0 % 96; isr[bj] = d0 >= 64; const int i0 = (isr[bj] ? d0 - 64 : 0) >> 1; hi8[bj] = i0 >= 8; f0[bj] = i0 & 7; }
        f32x4 csn[2], snn[2];
#define QUP_ISSUE(it) do { const int t_ = (int)(((size_t)u.pm * 256 + ((it) >> 2) * 128 + wr * 64 + ((it) & 3) * 16 + fr) & 4095); \
            _Pragma("unroll") for (int bj = 0; bj < 2; ++bj) { const int p_ = hi8[bj] ? (t_ & 63) : (t_ >> 6); \
                csn[bj] = *(const f32x4*)(rope + p_ * 8 + f0[bj]); snn[bj] = *(const f32x4*)(rope + 512 + p_ * 8 + f0[bj]); } } while (0)
        QUP_ISSUE(0);
        asm volatile("" ::: "memory");
#pragma unroll
        for (int it = 0; it < 8; ++it) {
            const int ai = it >> 2, m = it & 3;
            asm volatile("" : "+v"(csn[0]), "+v"(csn[1]), "+v"(snn[0]), "+v"(snn[1]));
            const f32x4 cs0 = csn[0], cs1 = csn[1], sn0 = snn[0], sn1 = snn[1];
            if (it < 7) QUP_ISSUE(it + 1);
            const size_t xrow = (size_t)u.pm * 256 + ai * 128 + wr * 64 + m * 16 + fr;
            const float rs = MLA_QS * __builtin_amdgcn_rsqf(rs8[it] * (1.f / 256.f) + RMS_EPS);
#pragma unroll
            for (int bj = 0; bj < 2; ++bj) { const int c0 = u.pn * 256 + bj * 128 + wc * 32 + 8 * fq;
                f32x4 v0 = acc[ai][bj][m][0], v1 = acc[ai][bj][m][1];
                if (isr[bj]) rope8(v0, v1, bj ? cs1 : cs0, bj ? sn1 : sn0);
                *(u32x4*)(QM + xrow * 768 + c0) = pack8(v0 * rs, v1 * rs); }
            asm volatile("" ::: "memory");
        }
#undef QUP_ISSUE
    }
};
struct EpiKVUp {
    static constexpr bool PERM = true, HAS_MID = false, HAS_PRE = false;
    bf16_t *KMN, *VM; const float* ssq_kv;
    __device__ __forceinline__ void operator()(const f32x4 (&acc)[2][2][4][2], const Unit& u, int wr, int wc, int fr_, int fq) const {
        const int fr = opaque(fr_);
        bf16_t* base = (u.pn < 2 ? KMN : VM) + (u.pn & 1) * 256 + wc * 32 + 8 * fq;
        float rs8[8];
#pragma unroll
        for (int i = 0; i < 8; ++i) rs8[i] = ssq_kv[(size_t)u.pm * 256 + (i >> 2) * 128 + wr * 64 + (i & 3) * 16 + fr];
        asm volatile("" : "+v"(rs8[0]), "+v"(rs8[1]), "+v"(rs8[2]), "+v"(rs8[3]), "+v"(rs8[4]), "+v"(rs8[5]), "+v"(rs8[6]), "+v"(rs8[7]) :: "memory");
#pragma unroll
        for (int ai = 0; ai < 2; ++ai)
#pragma unroll
            for (int m = 0; m < 4; ++m) {
                const size_t mrow = (size_t)u.pm * 256 + ai * 128 + wr * 64 + m * 16 + fr;
                const float rs = __builtin_amdgcn_rsqf(rs8[ai * 4 + m] * (1.f / 128.f) + RMS_EPS);
#pragma unroll
                for (int bj = 0; bj < 2; ++bj) *(u32x4*)(base + mrow * 512 + bj * 128) = pack8(acc[ai][bj][m][0] * rs, acc[ai][bj][m][1] * rs);
            }
    }
};
static_assert(WS_KVX - WS_QC == (size_t)128 * 256 * 256 * 2 && WS_WUKV - WS_WUQ == (size_t)4 * 256 * 256 * 2, "tile-index aliasing of the up-projection operands");
struct SchedUp {
    int G, c;
    __device__ __forceinline__ bool next(int i, Unit& u) const {
        const int L = i * G + c; if (L >= 928) return false;
        if (L < 544) { u.pn = L & 3; u.pm = 128 + (L >> 2); u.pb = 4 + u.pn; }
        else { const int q = L - 544; u.pn = q % 3; u.pm = q / 3; u.pb = u.pn; }
        return true;
    }
};
struct EpiUp {
    static constexpr bool PERM = true, HAS_MID = false, HAS_PRE = false;
    EpiQUp Q; EpiKVUp KV;
    __device__ __forceinline__ void operator()(const f32x4 (&acc)[2][2][4][2], const Unit& u, int wr, int wc, int fr, int fq) const {
        if (u.pb >= 4) { Unit v = u; v.pm = u.pm - 128; KV(acc, v, wr, wc, fr, fq); } else Q(acc, u, wr, wc, fr, fq);
    }
};
struct EpiMerge {
    static constexpr bool PERM = true, HAS_MID = true, HAS_PRE = false;
    bf16_t* T; const bf16_t* GATES;
    __device__ __forceinline__ void mid(f32x4 (&acc)[2][2][4][2], const Unit& u, int wr, int wc, int fr_, int fq) const {
        const int fr = opaque(fr_);
        const bf16_t* gb = GATES + ((size_t)u.pm * 256 + wr * 64 + fr) * 2048 + u.pn * 256 + wc * 32 + 8 * fq;
        u32x4 R[2][4][2];
#pragma unroll
        for (int ai = 0; ai < 2; ++ai)
#pragma unroll
            for (int m = 0; m < 4; ++m)
#pragma unroll
                for (int bj = 0; bj < 2; ++bj) R[ai][m][bj] = *(const u32x4*)(gb + (size_t)(ai * 128 + m * 16) * 2048 + bj * 128);
        asm volatile("" ::: "memory");
#pragma unroll
        for (int ai = 0; ai < 2; ++ai)
#pragma unroll
            for (int m = 0; m < 4; ++m)
#pragma unroll
                for (int bj = 0; bj < 2; ++bj)
#pragma unroll
                    for (int k = 0; k < 4; ++k) { acc[ai][bj][m][k >> 1][(k & 1) * 2] *= bflo(R[ai][m][bj][k]); acc[ai][bj][m][k >> 1][(k & 1) * 2 + 1] *= bfhi(R[ai][m][bj][k]); }
    }
    __device__ __forceinline__ void operator()(const f32x4 (&acc)[2][2][4][2], const Unit& u, int wr, int wc, int fr_, int fq) const {
        const int fr = opaque(fr_);
        const bf16_t* gb = GATES + ((size_t)u.pm * 256 + wr * 64 + fr) * 2048 + 1024 + u.pn * 256 + wc * 32 + 8 * fq;
        u32x4 R[2][4][2];
#pragma unroll
        for (int ai = 0; ai < 2; ++ai)
#pragma unroll
            for (int m = 0; m < 4; ++m)
#pragma unroll
                for (int bj = 0; bj < 2; ++bj) R[ai][m][bj] = *(const u32x4*)(gb + (size_t)(ai * 128 + m * 16) * 2048 + bj * 128);
        asm volatile("" ::: "memory");
#pragma unroll
        for (int ai = 0; ai < 2; ++ai)
#pragma unroll
            for (int m = 0; m < 4; ++m) {
                const size_t xrow = (size_t)u.pm * 256 + ai * 128 + wr * 64 + m * 16 + fr;
#pragma unroll
                for (int bj = 0; bj < 2; ++bj) { const int c0 = u.pn * 256 + bj * 128 + wc * 32 + 8 * fq;
                    const u32x4 g2 = R[ai][m][bj];
                    f32x4 v0 = acc[ai][bj][m][0], v1 = acc[ai][bj][m][1];
                    v0[0] *= bflo(g2[0]); v0[1] *= bfhi(g2[0]); v0[2] *= bflo(g2[1]); v0[3] *= bfhi(g2[1]);
                    v1[0] *= bflo(g2[2]); v1[1] *= bfhi(g2[2]); v1[2] *= bflo(g2[3]); v1[3] *= bfhi(g2[3]);
                    *(u32x4*)(T + xrow * 1024 + c0) = pack8(v0, v1); }
            }
    }
};
struct EpiOut {
    static constexpr bool PERM = true, HAS_MID = false, HAS_PRE = false;
    bf16_t* MIXR;
    __device__ __forceinline__ void operator()(const f32x4 (&acc)[2][2][4][2], const Unit& u, int wr, int wc, int fr_, int fq) const {
        const int fr = opaque(fr_);
#pragma unroll
        for (int ai = 0; ai < 2; ++ai)
#pragma unroll
            for (int m = 0; m < 4; ++m) { const size_t row = (size_t)u.pm * 256 + ai * 128 + wr * 64 + m * 16 + fr;
#pragma unroll
                for (int bj = 0; bj < 2; ++bj) *(u32x4*)(MIXR + row * 1024 + u.pn * 256 + bj * 128 + wc * 32 + 8 * fq) = pack8(acc[ai][bj][m][0], acc[ai][bj][m][1]); }
    }
};
struct EpiSwiGLU {
    static constexpr bool PERM = true, HAS_MID = false, HAS_PRE = false;
    bf16_t* H;
    __device__ __forceinline__ void operator()(const f32x4 (&acc)[2][2][4][2], const Unit& u, int wr, int wc, int fr_, int fq) const {
        const int fr = opaque(fr_);
#pragma unroll
        for (int ai = 0; ai < 2; ++ai)
#pragma unroll
            for (int m = 0; m < 4; ++m) { const size_t row = (size_t)u.pm * 256 + ai * 128 + wr * 64 + m * 16 + fr;
                f32x4 h0, h1;
#pragma unroll
                for (int k = 0; k < 4; ++k) { const float g0 = acc[ai][0][m][0][k], g1 = acc[ai][0][m][1][k];
                    h0[k] = g0 * sigmoidf_(g0) * acc[ai][1][m][0][k]; h1[k] = g1 * sigmoidf_(g1) * acc[ai][1][m][1][k]; }
                *(u32x4*)(H + row * 1024 + u.pn * 128 + wc * 32 + 8 * fq) = pack8(h0, h1); }
    }
};
struct EpiDown {
    static constexpr bool PERM = true, HAS_MID = false, HAS_PRE = true;
    bf16_t* YE; const float* GV;
    __device__ __forceinline__ void pre_issue(float (&pre)[8], const Unit& u, int wr, int wc, int fr_, int fq) const {
        const unsigned off0 = (unsigned)(u.pm * 256 + wr * 64 + opaque(fr_)) * 4u;
#pragma unroll
        for (int i = 0; i < 8; ++i) { const unsigned off = off0 + (unsigned)((i >> 2) * 128 + (i & 3) * 16) * 4u;
            asm volatile("global_load_dword %0, %1, %2" : "=v"(pre[i]) : "v"(off), "s"(GV) : "memory"); }
    }
    __device__ __forceinline__ void pre_wait(float (&pre)[8]) const {
        asm volatile("s_waitcnt vmcnt(16)" : "+v"(pre[0]), "+v"(pre[1]), "+v"(pre[2]), "+v"(pre[3]), "+v"(pre[4]), "+v"(pre[5]), "+v"(pre[6]), "+v"(pre[7]) :: "memory");
    }
    __device__ __forceinline__ void run(const f32x4 (&acc)[2][2][4][2], const Unit& u, int wr, int wc, int fr_, int fq, const float (&pre)[8]) const {
        const int fr = opaque(fr_);
#pragma unroll
        for (int ai = 0; ai < 2; ++ai)
#pragma unroll
            for (int m = 0; m < 4; ++m) { const size_t row = (size_t)u.pm * 256 + ai * 128 + wr * 64 + m * 16 + fr; const float g = pre[ai * 4 + m];
#pragma unroll
                for (int bj = 0; bj < 2; ++bj) *(u32x4*)(YE + row * 1024 + u.pn * 256 + bj * 128 + wc * 32 + 8 * fq) = pack8(acc[ai][bj][m][0] * g, acc[ai][bj][m][1] * g); }
    }
    __device__ __forceinline__ void operator()(const f32x4 (&acc)[2][2][4][2], const Unit& u, int wr, int wc, int fr, int fq) const {}
};

namespace att {
constexpr int KVBLK = 64, QBLK = 32;
constexpr int SHM_V = 64 * 64 * 2, SHM_K = 64 * 256;
constexpr int L_V = 0, L_K = 2 * SHM_V, L_WS = L_K + 2 * SHM_K, L_OST = L_WS + NWAVES * 64 * 4, L_BL = L_OST + NWAVES * 4096, L_END = L_BL + 2048;
static_assert(L_END <= RING_BYTES, "attention LDS");
constexpr float THR = 8.f;
#define KSWZ(row, colB) ((row) * 256 + ((colB) ^ (((row) & 7) << 4)))
#define SBAR() __builtin_amdgcn_sched_barrier(0)
__device__ __forceinline__ int crow(int r, int hi) { return (r & 3) + 8 * (r >> 2) + 4 * hi; }
template <bool FIRST>
__device__ __forceinline__ void partialSM(f32x16& p0, f32x16& p1, float& m_reg, f32x16& negm, float& alpha) {
  float pmax = p0[0];
#pragma unroll
  for (int r = 1; r < 16; ++r) pmax = fmaxf(pmax, p0[r]);
#pragma unroll
  for (int r = 0; r < 16; ++r) pmax = fmaxf(pmax, p1[r]);
  { auto rr = __builtin_amdgcn_permlane32_swap(__float_as_uint(pmax), __float_as_uint(pmax), false, false);
    pmax = fmaxf(__uint_as_float(rr[0]), __uint_as_float(rr[1])); }
  if (!FIRST && __builtin_expect(__all(pmax <= THR), 1)) { alpha = 1.f; }
  else { const float d = FIRST ? pmax : fmaxf(pmax, 0.f); m_reg += d; alpha = __builtin_amdgcn_exp2f(-d);
#pragma unroll
    for (int r = 0; r < 16; ++r) { p0[r] -= d; p1[r] -= d; }
#pragma unroll
    for (int r = 0; r < 16; ++r) negm[r] = -m_reg;
    asm volatile("" : "+v"(negm)); }
#pragma unroll
  for (int r = 0; r < 16; ++r) p0[r] = __builtin_amdgcn_exp2f(p0[r]);
}
__device__ __forceinline__ void finishSM(f32x16& p0, f32x16& p1, float alpha, float& l_reg, bf16x8& pa0, bf16x8& pa1, bf16x8& pa2, bf16x8& pa3) {
#pragma unroll
  for (int r = 0; r < 16; ++r) p1[r] = __builtin_amdgcn_exp2f(p1[r]);
  float ps = 0;
#pragma unroll
  for (int r = 0; r < 16; ++r) ps += p0[r];
#pragma unroll
  for (int r = 0; r < 16; ++r) ps += p1[r];
  { auto rr = __builtin_amdgcn_permlane32_swap(__float_as_uint(ps), __float_as_uint(ps), false, false);
    ps = __uint_as_float(rr[0]) + __uint_as_float(rr[1]); }
  l_reg = l_reg * alpha + ps;
#define PK4(P, BASE, OUT) do { unsigned a0 = cvtpk(P[BASE + 0], P[BASE + 1]), a1 = cvtpk(P[BASE + 2], P[BASE + 3]);   \
    unsigned b0 = cvtpk(P[BASE + 4], P[BASE + 5]), b1 = cvtpk(P[BASE + 6], P[BASE + 7]);                              \
    auto r0 = __builtin_amdgcn_permlane32_swap(a0, b0, false, false); auto r1 = __builtin_amdgcn_permlane32_swap(a1, b1, false, false); \
    u32x4 w = {r0[0], r1[0], r0[1], r1[1]}; OUT = __builtin_bit_cast(bf16x8, w); } while (0)
  PK4(p0, 0, pa0); PK4(p0, 8, pa1); PK4(p1, 0, pa2); PK4(p1, 8, pa3);
#undef PK4
}
template <int NKS> __device__ __forceinline__ void qkt(f32x16& p0, f32x16& p1, const char* Ks, const bf16x8* qr, const f32x16& negm, int r32, int hi) {
  p0 = negm; p1 = negm;
#pragma unroll
  for (int d0 = 0; d0 < NKS; ++d0) { const int cb = (d0 * 16 + hi * 8) * 2;
    const bf16x8 b0 = *reinterpret_cast<const bf16x8*>(Ks + KSWZ(r32, cb));
    const bf16x8 b1 = *reinterpret_cast<const bf16x8*>(Ks + KSWZ(32 + r32, cb));
    p0 = __builtin_amdgcn_mfma_f32_32x32x16_bf16(b0, qr[d0], p0, 0, 0, 0);
    p1 = __builtin_amdgcn_mfma_f32_32x32x16_bf16(b1, qr[d0], p1, 0, 0, 0); }
}
__device__ __forceinline__ int v_st(int k, int c) { const int kk = (k & ~0xC) | ((k & 4) << 1) | ((k & 8) >> 1); return ((kk >> 3) * 2 + (c >> 5)) * 512 + ((kk & 7) * 32 + (c & 31)) * 2; }
__device__ __forceinline__ int v_rd_base(int lane) { return ((lane & 3) << 3) | (((lane >> 2) & 3) << 6) | (((lane >> 4) & 1) << 5) | (((lane >> 5) & 1) << 8); }
constexpr int v_rd_off(int d0, int ks, int half) { return d0 * 512 + ks * 2048 + half * 1024; }
template <int OFF> __device__ __forceinline__ s16x4 tr_read(int vb) {
  s16x4 r; asm volatile("ds_read_b64_tr_b16 %0, %1 offset:%2" : "=&v"(r) : "v"(vb), "i"(OFF) : "memory"); return r;
}
template <int D0> __device__ __forceinline__ void pv_one(f32x16& od, int vb, bf16x8 pa0, bf16x8 pa1, bf16x8 pa2, bf16x8 pa3) {
  const s16x4 l0 = tr_read<v_rd_off(D0, 0, 0)>(vb), h0 = tr_read<v_rd_off(D0, 0, 1)>(vb), l1 = tr_read<v_rd_off(D0, 1, 0)>(vb), h1 = tr_read<v_rd_off(D0, 1, 1)>(vb);
  const s16x4 l2 = tr_read<v_rd_off(D0, 2, 0)>(vb), h2 = tr_read<v_rd_off(D0, 2, 1)>(vb), l3 = tr_read<v_rd_off(D0, 3, 0)>(vb), h3 = tr_read<v_rd_off(D0, 3, 1)>(vb);
  asm volatile("s_waitcnt lgkmcnt(0)" ::: "memory"); SBAR();
#define PK(L, H) (bf16x8){L[0], L[1], L[2], L[3], H[0], H[1], H[2], H[3]}
  od = __builtin_amdgcn_mfma_f32_32x32x16_bf16(pa0, PK(l0, h0), od, 0, 0, 0);
  od = __builtin_amdgcn_mfma_f32_32x32x16_bf16(pa1, PK(l1, h1), od, 0, 0, 0);
  od = __builtin_amdgcn_mfma_f32_32x32x16_bf16(pa2, PK(l2, h2), od, 0, 0, 0);
  od = __builtin_amdgcn_mfma_f32_32x32x16_bf16(pa3, PK(l3, h3), od, 0, 0, 0);
#undef PK
}
__device__ __forceinline__ void pv_all(f32x16* o, int vb, bf16x8 pa0, bf16x8 pa1, bf16x8 pa2, bf16x8 pa3) {
  pv_one<0>(o[0], vb, pa0, pa1, pa2, pa3); pv_one<1>(o[1], vb, pa0, pa1, pa2, pa3);
}
struct Tensors { const bf16_t *QM, *KMN, *KVX, *VM, *NQ, *NK, *NV; bf16_t* Y; const float* rel_bias; };

template <bool NA>
__device__ __forceinline__ void attn_unit(const Tensors& T, int b, int h, int qb, char* lds) {
  constexpr int NKS = NA ? 4 : 6;
  const int tid = threadIdx.x, wid = __builtin_amdgcn_readfirstlane(tid >> 6), lane = tid & 63, r32 = lane & 31, hi = lane >> 5;
  char* V_lds = lds + L_V; char* K_lds = lds + L_K;
  float* ws = (float*)(lds + L_WS) + wid * 64; float* li_l = ws; float* al_l = ws + 32;
  float* BL = (float*)(lds + L_BL);
  float m_reg = 0.f, l_reg = 0; f32x16 o[2] = {}; bf16x8 qr[NKS]; f32x16 negm = {}; asm volatile("" : "+v"(negm));
  const size_t xrow0 = (size_t)b * SEQ + qb * 256 + wid * QBLK;
  {
    const bf16_t* Qw = NA ? T.NQ + (xrow0 + r32) * 512 + h * 64 + hi * 8 : T.QM + (xrow0 + r32) * 768 + h * 96 + hi * 8;
#pragma unroll
    for (int d0 = 0; d0 < NKS; ++d0) qr[d0] = *reinterpret_cast<const bf16x8*>(Qw + d0 * 16);
  }
  const size_t kbase = (size_t)b * SCOMB;
  int RLO = 0, nloc = 0, NT;
  if (NA) { RLO = min(max(4 * qb - 4, 0), 56); const int RHI = min(max(4 * qb - 1, 0), 56) + 7; nloc = RHI - RLO + 1; NT = 4 + nloc; }
  else NT = SCOMB / KVBLK;
  auto krow = [&](int t) -> size_t { if (!NA) return kbase + (size_t)t * 64; if (t < 4) return kbase + (size_t)t * 64; const int rr = min(RLO + t - 4, 63); return kbase + 256 + (size_t)rr * 64; };
  const int rw = 4 * qb + (wid >> 1), r0w = min(max(rw - 4, 0), 56);
  const int qc = (wid & 1) * 32 + r32, c0w = min(max(qc - 8, 0), 48);
  if (NA) { if (tid < 480) { const int dr = tid >> 5, i = tid & 31; BL[tid] = (i < 31) ? T.rel_bias[(h * 15 + dr) * 31 + i] * LOG2E : 0.f; } }
  const int sr = tid >> 3, sc8 = tid & 7;
  const int vst = v_st(sr, sc8 * 8), kst = KSWZ(sr, sc8 * 16), krst = KSWZ(tid >> 2, 128 + (tid & 3) * 16);
  const int vb0 = (int)(uintptr_t)V_lds + v_rd_base(lane);
  const bf16_t* Kg = NA ? T.NK + h * 64 + sc8 * 8 : T.KMN + h * 64 + sc8 * 8;
  const bf16_t* Vg = NA ? T.NV + h * 64 + sc8 * 8 : T.VM + h * 64 + sc8 * 8;
  const bf16_t* Rg = T.KVX + 128 + (tid & 3) * 8;
  struct { bf16x8 k, v, kr; } sr_[2];
#define SLOAD(i, t) do { const size_t row_ = krow(t); sr_[i].k = *reinterpret_cast<const bf16x8*>(Kg + (row_ + sr) * 512); sr_[i].v = *reinterpret_cast<const bf16x8*>(Vg + (row_ + sr) * 512); \
    if (!NA) { if (tid < 256) sr_[i].kr = *reinterpret_cast<const bf16x8*>(Rg + (row_ + (tid >> 2)) * 256); } } while (0)
#define SWRITE(bf, i) do { *(bf16x8*)(V_lds + (bf) * SHM_V + vst) = sr_[i].v; *(bf16x8*)(K_lds + (bf) * SHM_K + kst) = sr_[i].k; \
    if (!NA) { if (tid < 256) *(bf16x8*)(K_lds + (bf) * SHM_K + krst) = sr_[i].kr; } } while (0)
#define RESC(a) do { if (__any((a) < 1.f)) { if (hi == 0) al_l[r32] = (a); asm volatile("s_waitcnt lgkmcnt(0)" ::: "memory"); \
    _Pragma("unroll") for (int d = 0; d < 2; ++d) _Pragma("unroll") for (int r = 0; r < 16; ++r) o[d][r] *= al_l[crow(r, hi)]; } } while (0)
#define NAMASK(P0, P1, t) do { if (NA) { if ((t) >= 4) { const int rr_ = RLO + (t) - 4; const bool act_ = ((t) < 4 + nloc) && rr_ >= r0w && rr_ <= r0w + 7; \
    if (!act_) { _Pragma("unroll") for (int r = 0; r < 16; ++r) { P0[r] = -INFINITY; P1[r] = -INFINITY; } } \
    else { const float* bl_ = BL + (rr_ - rw + 7) * 32 + (4 * hi - qc + 15); const int vb_ = 4 * hi - c0w; float bv_[16]; \
        \
        \
      _Pragma("unroll") for (int r = 0; r < 16; ++r) { constexpr_cr(r); bv_[r] = bl_[cr_]; } \
      asm volatile("" : "+v"(bv_[0]), "+v"(bv_[1]), "+v"(bv_[2]), "+v"(bv_[3]), "+v"(bv_[4]), "+v"(bv_[5]), "+v"(bv_[6]), "+v"(bv_[7]), "+v"(bv_[8]), "+v"(bv_[9]), "+v"(bv_[10]), "+v"(bv_[11]), "+v"(bv_[12]), "+v"(bv_[13]), "+v"(bv_[14]), "+v"(bv_[15]) :: "memory"); \
      _Pragma("unroll") for (int r = 0; r < 16; ++r) { constexpr_cr(r); P0[r] = ((unsigned)(vb_ + cr_) < 16u) ? P0[r] + bv_[r] : -INFINITY; } \
      _Pragma("unroll") for (int r = 0; r < 16; ++r) { constexpr_cr(r); bv_[r] = bl_[cr_ + 32]; } \
      asm volatile("" : "+v"(bv_[0]), "+v"(bv_[1]), "+v"(bv_[2]), "+v"(bv_[3]), "+v"(bv_[4]), "+v"(bv_[5]), "+v"(bv_[6]), "+v"(bv_[7]), "+v"(bv_[8]), "+v"(bv_[9]), "+v"(bv_[10]), "+v"(bv_[11]), "+v"(bv_[12]), "+v"(bv_[13]), "+v"(bv_[14]), "+v"(bv_[15]) :: "memory"); \
      _Pragma("unroll") for (int r = 0; r < 16; ++r) { constexpr_cr(r); P1[r] = ((unsigned)(vb_ + cr_ + 32) < 16u) ? P1[r] + bv_[r] : -INFINITY; } } } } } while (0)
#define constexpr_cr(r) const int cr_ = ((r) & 3) + 8 * ((r) >> 2)
  f32x16 pA0, pA1, pB0, pB1; float alA, alB; bf16x8 pa0, pa1, pa2, pa3;
  SLOAD(0, 0); SLOAD(1, 1); SWRITE(0, 0); __syncthreads();
  qkt<NKS>(pA0, pA1, K_lds, qr, negm, r32, hi); partialSM<true>(pA0, pA1, m_reg, negm, alA);
  if (2 < NT) SLOAD(0, 2);
  SWRITE(1, 1); __syncthreads();
  for (int j = 1; j + 1 < NT; j += 2) {
    SBAR(); qkt<NKS>(pB0, pB1, K_lds + SHM_K, qr, negm, r32, hi); NAMASK(pB0, pB1, j);
    finishSM(pA0, pA1, alA, l_reg, pa0, pa1, pa2, pa3); SBAR();
    SLOAD(1, j + 2); SBAR();
    pv_all(o, vb0, pa0, pa1, pa2, pa3); partialSM<false>(pB0, pB1, m_reg, negm, alB);
    __syncthreads(); SWRITE(0, 0);
    RESC(alB); __syncthreads();
    SBAR(); qkt<NKS>(pA0, pA1, K_lds, qr, negm, r32, hi); NAMASK(pA0, pA1, j + 1);
    finishSM(pB0, pB1, alB, l_reg, pa0, pa1, pa2, pa3); SBAR();
    if (j + 3 < NT) SLOAD(0, j + 3); SBAR();
    pv_all(o, vb0 + SHM_V, pa0, pa1, pa2, pa3); partialSM<false>(pA0, pA1, m_reg, negm, alA);
    __syncthreads(); SWRITE(1, 1);
    RESC(alA); __syncthreads();
  }
  if (NA && (NT & 1)) {
    SBAR(); finishSM(pA0, pA1, alA, l_reg, pa0, pa1, pa2, pa3); SBAR();
    pv_all(o, vb0, pa0, pa1, pa2, pa3);
  } else {
  SBAR(); qkt<NKS>(pB0, pB1, K_lds + SHM_K, qr, negm, r32, hi); NAMASK(pB0, pB1, NT - 1);
  finishSM(pA0, pA1, alA, l_reg, pa0, pa1, pa2, pa3); SBAR();
  pv_all(o, vb0, pa0, pa1, pa2, pa3); partialSM<false>(pB0, pB1, m_reg, negm, alB);
  __syncthreads(); RESC(alB);
  finishSM(pB0, pB1, alB, l_reg, pa0, pa1, pa2, pa3); SBAR();
  pv_all(o, vb0 + SHM_V, pa0, pa1, pa2, pa3);
  }
  if (hi == 0) li_l[r32] = l_reg; asm volatile("s_waitcnt lgkmcnt(0)" ::: "memory");
  float rli[16];
#pragma unroll
  for (int r = 0; r < 16; ++r) rli[r] = __builtin_amdgcn_rcpf(li_l[crow(r, hi)]);
  { bf16_t* stg = (bf16_t*)(lds + L_OST) + wid * 2048;
#pragma unroll
    for (int r = 0; r < 16; ++r) { const int orow = crow(r, hi);
#pragma unroll
      for (int d0 = 0; d0 < 2; ++d0) stg[orow * 64 + d0 * 32 + r32] = (bf16_t)(cvtpk(o[d0][r] * rli[r], 0.f) & 0xffffu); }
    asm volatile("s_waitcnt lgkmcnt(0)" ::: "memory");
    bf16_t* Yw = T.Y + xrow0 * 1024 + (NA ? 512 : 0) + h * 64;
#pragma unroll
    for (int i = 0; i < 4; ++i) { const int row = i * 8 + (lane >> 3), ch = lane & 7; const u32x4 v = *(const u32x4*)(stg + row * 64 + ch * 8); *(u32x4*)(Yw + (size_t)row * 1024 + ch * 8) = v; } }
  __syncthreads();
#undef SLOAD
#undef SWRITE
#undef RESC
#undef NAMASK
#undef constexpr_cr
}
#undef KSWZ
#undef SBAR
}

__device__ __forceinline__ unsigned f2bf(float f) { return cvtpk(f, 0.f) & 0xffffu; }
enum RowMap { RM_ID = 0, RM_WIN, RM_WUQ, RM_WUKV, RM_GATE, RM_UP };
__device__ __forceinline__ int rowmap(int mode, int n) {
    switch (mode) {
    case RM_WIN: {
        if (n < 256) return 1280 + n;
        if (n < 384) return n - 256;
        if (n < 416) { const int d = n - 384; return 128 + (d < 16 ? 2 * d : 2 * (d - 16) + 1); }
        if (n < 1952) { const int jj = n - 416, w = jj >> 9, c = jj & 511; return (w == 0 ? 1536 : (w == 1 ? 256 : 768)) + c; }
        { const int g = n - 1952, c = g & 1023; return 2048 + (c >> 7) * 256 + (g >> 10) * 128 + (c & 127); }
    }
    case RM_WUQ: { const int h = n / 96, d = n % 96; if (d < 64) return n; const int dd = d - 64; return h * 96 + 64 + (dd < 16 ? 2 * dd : 2 * (dd - 16) + 1); }
    case RM_WUKV: { const int h = n >> 7, d = n & 127; return d < 64 ? h * 64 + d : 512 + h * 64 + (d - 64); }
    case RM_GATE: return (n >> 7) * 256 + (n & 127);
    case RM_UP: return (n >> 7) * 256 + 128 + (n & 127);
    default: return n;
    }
}
struct TItem { const float* W; bf16_t* WT; const float* kscale; int N, ldk, koff, mode, k0, n0; };
__device__ __forceinline__ void titem_set(TItem& D, const float* W, int N, bf16_t* WT, int ldk, int koff, int mode, const float* kscale, int item) {
    const int nblk = N / 32, kb = item / nblk, nb = item - kb * nblk;
    D.W = W; D.WT = WT; D.kscale = kscale; D.N = N; D.ldk = ldk; D.koff = koff; D.mode = mode; D.k0 = 64 * kb; D.n0 = 32 * nb;
}
__device__ __forceinline__ void titem_issue(const TItem& D, float (&xn)[32], int lane) {
    const float* p = D.W + (size_t)(D.k0 + (lane >> 5)) * D.N + D.n0 + (lane & 31);
#pragma unroll
    for (int i = 0; i < 32; ++i) xn[i] = __builtin_nontemporal_load(p + (size_t)(2 * i) * D.N);
    asm volatile("" ::: "memory");
}
__device__ __forceinline__ void titem_consume(const TItem& D, float (&xn)[32], float (&v)[32], int lane) {
    asm volatile("" : "+v"(xn[0]), "+v"(xn[1]), "+v"(xn[2]), "+v"(xn[3]), "+v"(xn[4]), "+v"(xn[5]), "+v"(xn[6]), "+v"(xn[7]), "+v"(xn[8]), "+v"(xn[9]), "+v"(xn[10]), "+v"(xn[11]), "+v"(xn[12]), "+v"(xn[13]), "+v"(xn[14]), "+v"(xn[15]) :: "memory");
    asm volatile("" : "+v"(xn[16]), "+v"(xn[17]), "+v"(xn[18]), "+v"(xn[19]), "+v"(xn[20]), "+v"(xn[21]), "+v"(xn[22]), "+v"(xn[23]), "+v"(xn[24]), "+v"(xn[25]), "+v"(xn[26]), "+v"(xn[27]), "+v"(xn[28]), "+v"(xn[29]), "+v"(xn[30]), "+v"(xn[31]) :: "memory");
#pragma unroll
    for (int i = 0; i < 32; ++i) v[i] = xn[i];
    if (D.kscale) {
#pragma unroll
        for (int i = 0; i < 32; ++i) v[i] *= D.kscale[D.k0 + 2 * i + (lane >> 5)]; }
}
__device__ __forceinline__ void titem_body(const TItem& D, const float (&v)[32], LAS float* scr, int lane) {
#pragma unroll
    for (int i = 0; i < 32; ++i) scr[(2 * i + (lane >> 5)) * 33 + (lane & 31)] = v[i];
    LDS_WAIT(); asm volatile("" ::: "memory");
    const int c = lane & 7;
#pragma unroll
    for (int j = 0; j < 4; ++j) { const int n = (lane >> 3) + 8 * j; const LAS float* s = scr + (8 * c) * 33 + n;
        u32x4 o; o.x = cvtpk(s[0 * 33], s[1 * 33]); o.y = cvtpk(s[2 * 33], s[3 * 33]); o.z = cvtpk(s[4 * 33], s[5 * 33]); o.w = cvtpk(s[6 * 33], s[7 * 33]);
        __builtin_nontemporal_store(o, (u32x4*)(D.WT + (size_t)rowmap(D.mode, D.n0 + n) * D.ldk + D.koff + D.k0 + 8 * c)); }
    LDS_WAIT(); asm volatile("" ::: "memory");
}
enum { I_X = 0, I_C, I_CTX, I_CCTX, I_WMOD, I_BMOD, I_WIN, I_QG, I_WUQ, I_KVG, I_WUKV, I_BIAS, I_WPM, I_WPN, I_WOUT, I_LN1G, I_LN1B, I_WR, I_WEG, I_WEU, I_WED, I_LN2G, I_LN2B };

__device__ __forceinline__ void p0_prologue(Frame& F) {
    unsigned char* ws = F.ws;
    if (F.vcu < 192) {
        LAS float* S = (LAS float*)(F.lds);
        LAS float* red = (LAS float*)(F.lds + 9 * 1024 * 4);
        const int kq = F.tid >> 5, nn = F.tid & 31, n0 = F.vcu * 32;
        float w[64], cv[18];
        { const float* wm = F.in[I_WMOD] + n0 + nn + (size_t)(kq * 64) * 6144;
#pragma unroll
          for (int j = 0; j < 64; ++j) w[j] = __builtin_nontemporal_load(wm + (size_t)j * 6144); }
#pragma unroll
        for (int j = 0; j < 18; ++j) cv[j] = (j < 16) ? F.in[I_C][F.tid + 512 * j] : F.in[I_CCTX][F.tid + 512 * (j - 16)];
#pragma unroll
        for (int j = 0; j < 18; ++j) { const float v = cv[j]; S[F.tid + 512 * j] = v / (1.f + __expf(-v)); }
        __syncthreads();
        float a[9];
#pragma unroll
        for (int r = 0; r < 9; ++r) a[r] = 0.f;
#pragma unroll
        for (int j4 = 0; j4 < 16; ++j4)
#pragma unroll
            for (int r = 0; r < 9; ++r) { const f32x4 sv = *(const LAS f32x4*)(S + r * 1024 + kq * 64 + j4 * 4);
                a[r] += sv[0] * w[j4 * 4 + 0]; a[r] += sv[1] * w[j4 * 4 + 1]; a[r] += sv[2] * w[j4 * 4 + 2]; a[r] += sv[3] * w[j4 * 4 + 3]; }
#pragma unroll
        for (int r = 0; r < 9; ++r) red[(kq * 9 + r) * 32 + nn] = a[r];
        __syncthreads();
        if (F.tid < 288) { const int r = F.tid >> 5; float s = F.in[I_BMOD][n0 + nn];
            for (int q = 0; q < 16; ++q) s += red[(q * 9 + r) * 32 + nn];
            ((float*)(ws + WS_MOD))[r * 6144 + n0 + nn] = s; }
        asm volatile("s_waitcnt vmcnt(0)" ::: "memory");
        __syncthreads();
        if (F.tid == 0) { __builtin_amdgcn_fence(__ATOMIC_RELEASE, "agent"); asm volatile("s_waitcnt vmcnt(0)" ::: "memory"); (void)xb_add((unsigned*)(ws + WS_CTL) + CW_MODFLAG, 1u); }
    }
    if (F.vcu == 255 && F.tid < 512) { const int p = F.tid >> 3, f = F.tid & 7; const float inv = powf(10000.f, -(float)f / 8.f), ang = (float)p * inv;
        float* rp = (float*)(ws + WS_ROPE); rp[p * 8 + f] = cosf(ang); rp[512 + p * 8 + f] = sinf(ang); }
    { const int gt = F.vcu * 512 + F.tid, NGT = F.G * 512;
      u32x4 z = {0u, 0u, 0u, 0u};
      for (int i = gt; i < 96 * 128; i += NGT) *(u32x4*)(ws + WS_WIN + (size_t)160 * 2048 + (size_t)i * 16) = z;
      for (int i = gt; i < 1024 * 16; i += NGT) { const int row = i >> 4, ch = i & 15; *(u32x4*)(ws + WS_WUKV + (size_t)row * 512 + 256 + ch * 16) = z; } }
    LAS float* scr = (LAS float*)(F.lds + F.wave * 16384);
    const int gw = F.vcu * NWAVES + F.wave, NGW = F.G * NWAVES;
    constexpr int I_IN = 16 * 125, I_UQ = 4 * 24, I_UKV = 2 * 32, I_PR = 8 * 32, I_OUT = 16 * 32, I_EX = 16 * 32;
    constexpr int NSMALL = I_IN + I_UQ + I_UKV + 2 * I_PR + I_OUT;
    constexpr int NITEMS = NSMALL + 16 * I_EX;
    auto decode = [&](TItem& D, const int it) __attribute__((always_inline)) {
        int r = it;
        if (r < I_IN) { titem_set(D, F.in[I_WIN], D_IN, (bf16_t*)(ws + WS_WIN), 1024, 0, RM_WIN, nullptr, r); return; } r -= I_IN;
        if (r < I_UQ) { titem_set(D, F.in[I_WUQ], 768, (bf16_t*)(ws + WS_WUQ), 256, 0, RM_WUQ, F.in[I_QG], r); return; } r -= I_UQ;
        if (r < I_UKV) { titem_set(D, F.in[I_WUKV], 1024, (bf16_t*)(ws + WS_WUKV), 256, 0, RM_WUKV, F.in[I_KVG], r); return; } r -= I_UKV;
        if (r < I_PR) { titem_set(D, F.in[I_WPM], 1024, (bf16_t*)(ws + WS_WPROJ), 1024, 0, RM_ID, nullptr, r); return; } r -= I_PR;
        if (r < I_PR) { titem_set(D, F.in[I_WPN], 1024, (bf16_t*)(ws + WS_WPROJ), 1024, 512, RM_ID, nullptr, r); return; } r -= I_PR;
        if (r < I_OUT) { titem_set(D, F.in[I_WOUT], 1024, (bf16_t*)(ws + WS_WOUT), 1024, 0, RM_ID, nullptr, r); return; } r -= I_OUT;
        const int e = r / I_EX, ii = r % I_EX;
        titem_set(D, F.in[I_WEG] + (size_t)e * 1024 * 1024, 1024, (bf16_t*)(ws + WS_WGU) + (size_t)e * 2048 * 1024, 1024, 0, RM_GATE, nullptr, ii);
    };
    if (gw < NITEMS) {
        TItem Dc, Dn; float xn[32], v[32];
        decode(Dc, gw); titem_issue(Dc, xn, F.lane); titem_consume(Dc, xn, v, F.lane);
        int it = gw;
        for (; it + NGW < NITEMS; it += NGW) { decode(Dn, it + NGW); titem_issue(Dn, xn, F.lane); titem_body(Dc, v, scr, F.lane); titem_consume(Dn, xn, v, F.lane); Dc = Dn; }
        titem_body(Dc, v, scr, F.lane);
    }
}

__device__ __forceinline__ void p1_adaln(Frame& F) {
    const int gw = F.vcu * NWAVES + F.wave, G = F.G, lane = F.lane;
    const float* mod = (const float*)(F.ws + WS_MOD); bf16_t* U = (bf16_t*)(F.ws + WS_U);
    const int b = gw / G, r0 = gw - b * G;
    auto run = [&](const int j0, const int j1, const float* mr, const float* src0) __attribute__((always_inline)) {
        if (j0 >= j1) return;
        f32x4 sh[4], sc[4], v[4], xn[4];
#pragma unroll
        for (int q = 0; q < 4; ++q) { sh[q] = *((const f32x4*)mr + lane + 64 * q); sc[q] = *((const f32x4*)(mr + 1024) + lane + 64 * q) + 1.f; }
#define P1_ISSUE(j) do { const f32x4* xr_ = (const f32x4*)(src0 + (size_t)(j) * DM) + lane; \
            _Pragma("unroll") for (int q = 0; q < 4; ++q) xn[q] = __builtin_nontemporal_load(xr_ + 64 * q); asm volatile("" ::: "memory"); } while (0)
#define P1_CONSUME() do { asm volatile("" : "+v"(xn[0]), "+v"(xn[1]), "+v"(xn[2]), "+v"(xn[3]) :: "memory"); _Pragma("unroll") for (int q = 0; q < 4; ++q) v[q] = xn[q]; } while (0)
#define P1_BODY(j) do { float s = 0.f; \
            _Pragma("unroll") for (int q = 0; q < 4; ++q) s += (v[q][0] + v[q][1]) + (v[q][2] + v[q][3]); \
            const float mean = wave_sum(s) * (1.f / DM); float s2 = 0.f; \
            _Pragma("unroll") for (int q = 0; q < 4; ++q) { v[q] = v[q] - mean; s2 += (v[q][0] * v[q][0] + v[q][1] * v[q][1]) + (v[q][2] * v[q][2] + v[q][3] * v[q][3]); } \
            const float rstd = 1.f / sqrtf(wave_sum(s2) * (1.f / DM) + LN_EPS); \
            u32x2* o8 = (u32x2*)(U + ((size_t)b * SCOMB + (j)) * DM) + lane; \
            _Pragma("unroll") for (int q = 0; q < 4; ++q) { const f32x4 y = v[q] * rstd * sc[q] + sh[q]; u32x2 w; w.x = cvtpk(y[0], y[1]); w.y = cvtpk(y[2], y[3]); o8[64 * q] = w; } } while (0)
        P1_ISSUE(j0); P1_CONSUME();
        int j = j0;
        for (; j + G < j1; j += G) { P1_ISSUE(j + G); P1_BODY(j); P1_CONSUME(); }
        P1_BODY(j);
#undef P1_ISSUE
#undef P1_CONSUME
#undef P1_BODY
    };
    run(r0, CTXL, mod + 8 * 6144, F.in[I_CTX] + (size_t)b * CTXL * DM);
    const int jl = r0 + ((CTXL - r0 + G - 1) / G) * G;
    run(r0 >= CTXL ? r0 : jl, SCOMB, mod + b * 6144, F.in[I_X] + ((ptrdiff_t)b * SEQ - CTXL) * DM);
}

__device__ __forceinline__ unsigned pkh(float a, float b) { return __builtin_bit_cast(unsigned, __builtin_amdgcn_cvt_pkrtz(a, b)); }
__device__ __forceinline__ float hlo(unsigned w) { return (float)__builtin_bit_cast(h16x2, w)[0]; }
__device__ __forceinline__ float hhi(unsigned w) { return (float)__builtin_bit_cast(h16x2, w)[1]; }
__device__ __forceinline__ void p7_ln_router(Frame& F) {
    LAS f32x4* Wl = (LAS f32x4*)F.lds;
    for (int i = F.tid; i < 1024 * 4; i += 512) { const int c = i >> 2, e4 = i & 3, l = (c & 255) >> 2, k = c & 3, j = c >> 8;
        Wl[((j * 4 + k) * 4 + e4) * 64 + l] = *(const f32x4*)(F.in[I_WR] + (size_t)c * 16 + e4 * 4); }
    __syncthreads();
    const int gw = F.vcu * NWAVES + F.wave, NGW = F.G * NWAVES, lane = F.lane;
    const float* mod = (const float*)(F.ws + WS_MOD); bf16_t* U2 = (bf16_t*)(F.ws + WS_U2); float* AFF = (float*)(F.ws + WS_AFF); const bf16_t* MIXR = (const bf16_t*)(F.ws + WS_MIXR);
    f32x4 g1[4], b1[4];
#pragma unroll
    for (int q = 0; q < 4; ++q) { g1[q] = *((const f32x4*)F.in[I_LN1G] + lane + 64 * q); b1[q] = *((const f32x4*)F.in[I_LN1B] + lane + 64 * q); }
    const int b = gw / F.G, r0 = gw - b * F.G;
    const float* mr = mod + b * 6144;
    f32x4 g1m[4], sh2[4], sc2[4];
#pragma unroll
    for (int q = 0; q < 4; ++q) { g1m[q] = *((const f32x4*)(mr + 2 * 1024) + lane + 64 * q); sh2[q] = *((const f32x4*)(mr + 3 * 1024) + lane + 64 * q); sc2[q] = *((const f32x4*)(mr + 4 * 1024) + lane + 64 * q) + 1.f; }
    f32x4 xn[4]; u32x2 wn[4]; f32x4 v[4];
#define P7_ISSUE(mm) do { const f32x4* xin_ = (const f32x4*)(F.in[I_X] + (size_t)(mm) * DM) + lane; const u32x2* mxr_ = (const u32x2*)(MIXR + (size_t)(mm) * DM) + lane; \
        _Pragma("unroll") for (int q = 0; q < 4; ++q) { xn[q] = __builtin_nontemporal_load(xin_ + 64 * q); wn[q] = __builtin_nontemporal_load(mxr_ + 64 * q); } asm volatile("" ::: "memory"); } while (0)
#define P7_CONSUME() do { asm volatile("" : "+v"(xn[0]), "+v"(xn[1]), "+v"(xn[2]), "+v"(xn[3]), "+v"(wn[0]), "+v"(wn[1]), "+v"(wn[2]), "+v"(wn[3]) :: "memory");     \
        _Pragma("unroll") for (int q = 0; q < 4; ++q) { const f32x4 xv = xn[q]; const u32x2 w = wn[q]; const f32x4 g1v = g1m[q]; \
            v[q][0] = xv[0] * ALPHA + g1v[0] * bflo(w.x); v[q][1] = xv[1] * ALPHA + g1v[1] * bfhi(w.x); v[q][2] = xv[2] * ALPHA + g1v[2] * bflo(w.y); v[q][3] = xv[3] * ALPHA + g1v[3] * bfhi(w.y); } } while (0)
    auto body = [&](const int m) __attribute__((always_inline)) {
        u32x2* mxr = (u32x2*)(MIXR + (size_t)m * DM) + lane;
        float s = 0.f;
#pragma unroll
        for (int q = 0; q < 4; ++q) s += (v[q][0] + v[q][1]) + (v[q][2] + v[q][3]);
        float mean = wave_sum(s) * (1.f / DM), s2 = 0.f;
#pragma unroll
        for (int q = 0; q < 4; ++q) { v[q] = v[q] - mean; s2 += (v[q][0] * v[q][0] + v[q][1] * v[q][1]) + (v[q][2] * v[q][2] + v[q][3] * v[q][3]); }
        float rstd = 1.f / sqrtf(wave_sum(s2) * (1.f / DM) + LN_EPS);
        s = 0.f;
#pragma unroll
        for (int q = 0; q < 4; ++q) { v[q] = v[q] * rstd * g1[q] + b1[q]; s += (v[q][0] + v[q][1]) + (v[q][2] + v[q][3]);
            u32x2 w; w.x = pkh(v[q][0], v[q][1]); w.y = pkh(v[q][2], v[q][3]); ((u32x2*)mxr)[64 * q] = w; }
        mean = wave_sum(s) * (1.f / DM); s2 = 0.f;
#pragma unroll
        for (int q = 0; q < 4; ++q) { v[q] = v[q] - mean; s2 += (v[q][0] * v[q][0] + v[q][1] * v[q][1]) + (v[q][2] * v[q][2] + v[q][3] * v[q][3]); }
        rstd = 1.f / sqrtf(wave_sum(s2) * (1.f / DM) + LN_EPS);
        u32x2* o8 = (u32x2*)(U2 + (size_t)m * DM) + lane;
        float lg[16];
#pragma unroll
        for (int e = 0; e < 16; ++e) lg[e] = 0.f;
#pragma unroll
        for (int q = 0; q < 4; ++q) {
            const f32x4 y = v[q] * rstd * sc2[q] + sh2[q]; u32x2 w; w.x = cvtpk(y[0], y[1]); w.y = cvtpk(y[2], y[3]); o8[64 * q] = w;
#pragma unroll
            for (int k = 0; k < 4; ++k)
#pragma unroll
                for (int e4 = 0; e4 < 4; ++e4) { const f32x4 wv = Wl[((q * 4 + k) * 4 + e4) * 64 + lane];
                    lg[e4 * 4 + 0] += y[k] * wv[0]; lg[e4 * 4 + 1] += y[k] * wv[1]; lg[e4 * 4 + 2] += y[k] * wv[2]; lg[e4 * 4 + 3] += y[k] * wv[3]; }
            asm volatile("" ::: "memory"); }
        float r8[8], r4[4], r2[2], r1;
#pragma unroll
        for (int i = 0; i < 8; ++i) { auto q_ = __builtin_amdgcn_permlane32_swap(__float_as_uint(lg[i]), __float_as_uint(lg[i + 8]), false, false); r8[i] = __uint_as_float(q_[0]) + __uint_as_float(q_[1]); }
#pragma unroll
        for (int i = 0; i < 4; ++i) { auto q_ = __builtin_amdgcn_permlane16_swap(__float_as_uint(r8[i]), __float_as_uint(r8[i + 4]), false, false); r4[i] = __uint_as_float(q_[0]) + __uint_as_float(q_[1]); }
        { const bool up = (lane & 8) != 0;
#pragma unroll
          for (int i = 0; i < 2; ++i) { const float snd = up ? r4[i] : r4[i + 2], keep = up ? r4[i + 2] : r4[i]; r2[i] = keep + dppf<DPP_ROR8>(snd); } }
        { const bool up = (lane & 4) != 0; const float snd = up ? r2[0] : r2[1], keep = up ? r2[1] : r2[0]; r1 = keep + lane_xor4(snd); }
        r1 += dppf<DPP_XOR2>(r1); r1 += dppf<DPP_XOR1>(r1);
        const float mx = wave_max_q(r1);
        const float ex = expf(r1 - mx); const float sm = wave_sum_q(ex);
        AFF[(size_t)m * 16 + (lane >> 2)] = ex / sm;
    };
    const int nr = (r0 < SEQ) ? (SEQ - r0 + F.G - 1) / F.G : 0, m0 = b * SEQ + r0;
    if (nr > 0) {
        P7_ISSUE(m0); P7_CONSUME();
        for (int i = 0; i + 1 < nr; ++i) { P7_ISSUE(m0 + (i + 1) * F.G); body(m0 + i * F.G); P7_CONSUME(); }
        body(m0 + (nr - 1) * F.G);
    }
#undef P7_ISSUE
#undef P7_CONSUME
}

__device__ __forceinline__ int block_exscan(int v, LAS int* wsum, int tid, int lane, int wave, int& total) {
    int inc = v;
#pragma unroll
    for (int o = 1; o < 64; o <<= 1) { const int t = __shfl_up(inc, o); if (lane >= o) inc += t; }
    __syncthreads();
    if (lane == 63) wsum[wave] = inc;
    __syncthreads();
    int pre = 0, tot = 0;
#pragma unroll
    for (int w = 0; w < NWAVES; ++w) { const int s = wsum[w]; if (w < wave) pre += s; tot += s; }
    total = tot;
    return pre + inc - v;
}
__device__ __forceinline__ void p8_topk_gather(Frame& F) {
    if ((F.vcu & 1) || F.vcu >= 256) {
        const int cw = (F.vcu >> 1) * NWAVES + F.wave, NCW = (F.G >> 1) * NWAVES;
        constexpr int NIT = 16 * 16 * 32;
        if ((F.vcu & 1) && cw < NIT) {
            LAS float* scr = (LAS float*)(F.lds + F.wave * 16384);
            auto dec = [&](TItem& D, const int it) __attribute__((always_inline)) { const int e = it >> 9, ii = it & 511;
                titem_set(D, F.in[I_WED] + (size_t)e * 1024 * 1024, 1024, (bf16_t*)(F.ws + WS_WD) + (size_t)e * 1024 * 1024, 1024, 0, RM_ID, nullptr, ii); };
            TItem Dc, Dn; float xn[32], v[32];
            dec(Dc, cw); titem_issue(Dc, xn, F.lane); titem_consume(Dc, xn, v, F.lane);
            int it = cw;
            for (; it + NCW < NIT; it += NCW) { dec(Dn, it + NCW); titem_issue(Dn, xn, F.lane); titem_body(Dc, v, scr, F.lane); titem_consume(Dn, xn, v, F.lane); Dc = Dn; }
            titem_body(Dc, v, scr, F.lane);
        }
        return;
    }
    const int tk = F.vcu >> 1, e = tk >> 3, b = tk & 7, tid = F.tid, lane = F.lane, wave = F.wave;
    LAS int* wsum = (LAS int*)(F.lds + 1024);
    const float* AFF = (const float*)(F.ws + WS_AFF) + (size_t)b * SEQ * 16 + e;
    unsigned key[8];
#pragma unroll
    for (int k = 0; k < 8; ++k) key[k] = __float_as_uint(AFF[(size_t)(tid * 8 + k) * 16]);
    LAS int* cbuf = (LAS int*)(F.lds + 2048);
    unsigned prefix = 0u, need = CAP;
#pragma unroll 1
    for (int bit = 30; bit >= -1; --bit) {
        const unsigned cand = (bit >= 0) ? (prefix | (1u << bit)) : (prefix + 1u);
        int cw = 0;
#pragma unroll
        for (int k = 0; k < 8; ++k) cw += __builtin_popcountll(__ballot(key[k] >= cand));
        const int par_ = bit & 1;
        if (lane == 0) cbuf[par_ * 8 + wave] = cw;
        __syncthreads();
        int tot = 0;
#pragma unroll
        for (int w = 0; w < NWAVES; ++w) tot += cbuf[par_ * 8 + w];
        if (bit >= 0) { if (tot >= CAP) prefix = cand; } else need = (unsigned)(CAP - tot);
    }
    __syncthreads();
    int ceq = 0;
#pragma unroll
    for (int k = 0; k < 8; ++k) ceq += (key[k] == prefix) ? 1 : 0;
    int tot; int req = block_exscan(ceq, wsum, tid, lane, wave, tot);
    int csel = 0; unsigned selm = 0u;
#pragma unroll
    for (int k = 0; k < 8; ++k) { bool s = key[k] > prefix; if (key[k] == prefix) { s = (unsigned)req < need; ++req; } if (s) { selm |= 1u << k; ++csel; } }
    int slot = block_exscan(csel, wsum, tid, lane, wave, tot);
    float* GV = (float*)(F.ws + WS_GV) + (size_t)tk * CAP; int* INV = (int*)(F.ws + WS_INV) + (size_t)b * SEQ * 16 + e; int* IDX = (int*)(F.ws + WS_IDX) + (size_t)tk * CAP;
#pragma unroll
    for (int k = 0; k < 8; ++k) { const int t = tid * 8 + k; const bool s = (selm >> k) & 1u;
        if (s && slot < CAP) { IDX[slot] = b * SEQ + t; GV[slot] = __uint_as_float(key[k]); }
        INV[(size_t)t * 16] = s ? slot : -1;
        if (s) ++slot; }
    __syncthreads();
}

__device__ __forceinline__ void p11_final(Frame& F) {
    const int gw = F.vcu * NWAVES + F.wave, lane = F.lane, G = F.G;
    const float* mod = (const float*)(F.ws + WS_MOD); const bf16_t* YE = (const bf16_t*)(F.ws + WS_YE); const int* INV = (const int*)(F.ws + WS_INV); const bf16_t* X1H = (const bf16_t*)(F.ws + WS_MIXR);
    const int b = gw / G, r0 = gw - b * G;
    const float* mr = mod + b * 6144;
    f32x4 g2m[4], g2l[4], b2l[4];
#pragma unroll
    for (int q = 0; q < 4; ++q) { g2m[q] = *((const f32x4*)(mr + 5 * 1024) + lane + 64 * q); g2l[q] = *((const f32x4*)F.in[I_LN2G] + lane + 64 * q); b2l[q] = *((const f32x4*)F.in[I_LN2B] + lane + 64 * q); }
    const bf16_t* YEb = YE + (size_t)b * CAP * DM; const bf16_t* ZROW = (const bf16_t*)(F.ws + WS_ZROW);
    LAS int* sl = (LAS int*)F.lds + F.wave * 1024;
    u32x2 wn[4], y[4][4]; int slotc = -1; unsigned mrest = 0u;
    f32x4 v[4], mo[4];
#define P11_ISSUE(mm, li) do { slotc = sl[(li) * 16 + (lane & 15)]; { const u32x2* mxr_ = (const u32x2*)(X1H + (size_t)(mm) * DM) + lane; \
        _Pragma("unroll") for (int q = 0; q < 4; ++q) wn[q] = __builtin_nontemporal_load(mxr_ + 64 * q); } \
        unsigned mk_ = (unsigned)(__ballot(slotc >= 0) & 0xFFFFull); \
        _Pragma("unroll") for (int k = 0; k < 4; ++k) { const bool has_ = mk_ != 0u; const int e_ = has_ ? __builtin_ctz(mk_) : 0; mk_ &= mk_ - 1u; if (!has_) mk_ = 0u; const int s_ = __builtin_amdgcn_readlane(slotc, e_); \
            const u32x2* y_ = (const u32x2*)(has_ ? YEb + ((size_t)(e_ * 8) * CAP + s_) * DM : ZROW) + lane; _Pragma("unroll") for (int q = 0; q < 4; ++q) y[k][q] = y_[64 * q]; } \
        mrest = mk_; asm volatile("" ::: "memory"); } while (0)
#define P11_CONSUME() do { asm volatile("" ::: "memory"); \
        _Pragma("unroll") for (int q = 0; q < 4; ++q) { const u32x2 w = wn[q]; v[q][0] = hlo(w.x); v[q][1] = hhi(w.x); v[q][2] = hlo(w.y); v[q][3] = hhi(w.y); \
            mo[q][0] = bflo(y[0][q].x); mo[q][1] = bfhi(y[0][q].x); mo[q][2] = bflo(y[0][q].y); mo[q][3] = bfhi(y[0][q].y); \
            _Pragma("unroll") for (int k = 1; k < 4; ++k) { mo[q][0] += bflo(y[k][q].x); mo[q][1] += bfhi(y[k][q].x); mo[q][2] += bflo(y[k][q].y); mo[q][3] += bfhi(y[k][q].y); } } \
        while (mrest) { const int e0 = __builtin_ctz(mrest); mrest &= mrest - 1; const int s0 = __builtin_amdgcn_readlane(slotc, e0); \
            const u32x2* y0 = (const u32x2*)(YEb + ((size_t)(e0 * 8) * CAP + s0) * DM) + lane; u32x2 ya[4]; \
            _Pragma("unroll") for (int q = 0; q < 4; ++q) ya[q] = y0[64 * q]; \
            _Pragma("unroll") for (int q = 0; q < 4; ++q) { mo[q][0] += bflo(ya[q].x); mo[q][1] += bfhi(ya[q].x); mo[q][2] += bflo(ya[q].y); mo[q][3] += bfhi(ya[q].y); } } } while (0)
#define P11_FINISH(mm) do { f32x4* orow = (f32x4*)(F.out + (size_t)(mm) * DM) + lane; float s = 0.f; \
        _Pragma("unroll") for (int q = 0; q < 4; ++q) { v[q] = v[q] * ALPHA + g2m[q] * mo[q]; s += (v[q][0] + v[q][1]) + (v[q][2] + v[q][3]); } \
        const float mean = wave_sum(s) * (1.f / DM); float s2 = 0.f; \
        _Pragma("unroll") for (int q = 0; q < 4; ++q) { v[q] = v[q] - mean; s2 += (v[q][0] * v[q][0] + v[q][1] * v[q][1]) + (v[q][2] * v[q][2] + v[q][3] * v[q][3]); } \
        const float rstd = 1.f / sqrtf(wave_sum(s2) * (1.f / DM) + LN_EPS); \
        _Pragma("unroll") for (int q = 0; q < 4; ++q) __builtin_nontemporal_store(v[q] * rstd * g2l[q] + b2l[q], orow + 64 * q); } while (0)
    for (int c0 = r0; c0 < SEQ; c0 += 64 * G) {
        const int nr = min(64, (SEQ - c0 + G - 1) / G), mc = b * SEQ + c0;
        for (int i0 = 0; i0 < nr; i0 += 16) { int t_[4];
#pragma unroll
            for (int j = 0; j < 4; ++j) { const int i = i0 + 4 * j + (lane >> 4); t_[j] = (i < nr) ? INV[(size_t)(mc + i * G) * 16 + (lane & 15)] : -1; }
#pragma unroll
            for (int j = 0; j < 4; ++j) { const int i = i0 + 4 * j + (lane >> 4); sl[i * 16 + (lane & 15)] = t_[j]; } }
        __builtin_amdgcn_fence(__ATOMIC_RELEASE, "wavefront"); __builtin_amdgcn_wave_barrier(); __builtin_amdgcn_fence(__ATOMIC_ACQUIRE, "wavefront");
        P11_ISSUE(mc, 0); P11_CONSUME();
        for (int i = 0; i + 1 < nr; ++i) {
            P11_ISSUE(mc + (i + 1) * G, i + 1);
            P11_FINISH(mc + i * G);
            P11_CONSUME();
        }
        P11_FINISH(mc + (nr - 1) * G);
        __builtin_amdgcn_wave_barrier();
    }
#undef P11_ISSUE
#undef P11_CONSUME
#undef P11_FINISH
}

constexpr int N_PHASES = 12;
struct Args { const float* in[23]; float* out; unsigned char* ws; int ph_lo, ph_hi, rep, pad; };
__global__ void __launch_bounds__(NWAVES * 64, 2) fwd_mega(Args args) {
    extern __shared__ __attribute__((aligned(16))) unsigned char lds[];
    Frame F;
    F.lds = (LAS unsigned char*)lds;
    F.MISC = (volatile LAS unsigned*)(F.lds + MISC_OFF);
    F.tid = threadIdx.x; F.lane = F.tid & 63; F.wave = __builtin_amdgcn_readfirstlane(F.tid >> 6);
    F.G = gridDim.x; { const int bx = blockIdx.x; F.vcu = (bx % 8) * (F.G / 8) + bx / 8; }
    F.ws = args.ws; F.out = args.out;
#pragma unroll
    for (int i = 0; i < 23; ++i) F.in[i] = args.in[i];
    unsigned char* ws = args.ws;
    for (int u = F.tid; u < (LDS_BYTES - LDSCTL_OFF) / 4; u += NWAVES * 64) ((LAS unsigned*)(F.lds + LDSCTL_OFF))[u] = 0u;
    __syncthreads();
    XcdBarrier bar; bar.bar = (unsigned*)(ws + WS_CTL) + CW_BAR; bar.x = 0; bar.st = nullptr;
    if (MK_N_LAUNCHES == 1) bar = xcd_barrier_post((unsigned*)(ws + WS_CTL) + CW_BAR, F.MISC + 8);
    const int lo = args.ph_lo, hi = args.ph_hi;
#define IN(k) (lo <= (k) && (k) < hi)
#define SEAM(k) do { if (IN(k) && IN((k) + 1)) xcd_barrier(bar); } while (0)
    float* ssq_kv = (float*)(ws + WS_SSQ); float* ssq_q = ssq_kv + MC;
    const float* rope = (const float*)(ws + WS_ROPE);

    if (((MK_PHASE_MASK >> 0) & 1) && IN(0)) { p0_prologue(F); }
    if (IN(1)) {
        if (F.tid == 0) { unsigned* fl = (unsigned*)(ws + WS_CTL) + CW_MODFLAG; XB_SPIN(xb_ld(fl) < 192u, (unsigned*)(ws + WS_CTL) + CW_BAR); __builtin_amdgcn_fence(__ATOMIC_ACQUIRE, "agent"); asm volatile("s_waitcnt vmcnt(0)" ::: "memory"); }
        __syncthreads();
    }
    if (((MK_PHASE_MASK >> 1) & 1) && IN(1)) { p1_adaln(F); } SEAM(1);
    if (((MK_PHASE_MASK >> 2) & 1) && IN(2)) {
        SchedInProj S{F.G, (int)blockIdx.x};
        EpiInProj E{(bf16_t*)(ws + WS_KVX), (bf16_t*)(ws + WS_NK), (bf16_t*)(ws + WS_NV), (bf16_t*)(ws + WS_QC), (bf16_t*)(ws + WS_NQ), (bf16_t*)(ws + WS_GATES), ssq_kv, ssq_q, rope, args.rep ? 0.f : 1.f};
        pg8::gemm_phase<EpiInProj, SchedInProj, true>(F.lds + RING_OFF, (const bf16_t*)(ws + WS_U), (const bf16_t*)(ws + WS_WIN), 1024, S, E);
        if ((int)blockIdx.x >= 40 && F.G > 40) {
            asm volatile("s_waitcnt vmcnt(0)" ::: "memory"); __syncthreads();
            const int cw = ((int)blockIdx.x - 40) * NWAVES + F.wave, NCW = (F.G - 40) * NWAVES;
            constexpr int NIT = 16 * 512;
            if (cw < NIT) {
                LAS float* scr = (LAS float*)(F.lds + F.wave * 16384);
                auto dec = [&](TItem& D, const int it) __attribute__((always_inline)) { const int e = it >> 9, ii = it & 511;
                    titem_set(D, F.in[I_WEU] + (size_t)e * 1024 * 1024, 1024, (bf16_t*)(ws + WS_WGU) + (size_t)e * 2048 * 1024, 1024, 0, RM_UP, nullptr, ii); };
                TItem Dc, Dn; float xn[32], v[32];
                dec(Dc, cw); titem_issue(Dc, xn, F.lane); titem_consume(Dc, xn, v, F.lane);
                int it = cw;
                for (; it + NCW < NIT; it += NCW) { dec(Dn, it + NCW); titem_issue(Dn, xn, F.lane); titem_body(Dc, v, scr, F.lane); titem_consume(Dn, xn, v, F.lane); Dc = Dn; }
                titem_body(Dc, v, scr, F.lane);
            }
        }
    } SEAM(2);
    if (((MK_PHASE_MASK >> 3) & 1) && IN(3)) {
        SchedUp S{F.G, F.vcu}; EpiUp E{EpiQUp{(bf16_t*)(ws + WS_QM), ssq_q, rope}, EpiKVUp{(bf16_t*)(ws + WS_KMN), (bf16_t*)(ws + WS_VM), ssq_kv}};
        pg8::gemm_phase<EpiUp, SchedUp, true>(F.lds + RING_OFF, (const bf16_t*)(ws + WS_QC), (const bf16_t*)(ws + WS_WUQ), 256, S, E);
    } SEAM(3);
    if (((MK_PHASE_MASK >> 4) & 1) && IN(4)) {
        const att::Tensors T{(const bf16_t*)(ws + WS_QM), (const bf16_t*)(ws + WS_KMN), (const bf16_t*)(ws + WS_KVX), (const bf16_t*)(ws + WS_VM),
                             (const bf16_t*)(ws + WS_NQ), (const bf16_t*)(ws + WS_NK), (const bf16_t*)(ws + WS_NV), (bf16_t*)F.out, F.in[I_BIAS]};
        const int nU = (NBATCH * 8 * 16);
        if ((MK_PHASE_MASK >> 13) & 1) for (int L = F.vcu; L < nU; L += F.G) { const int xcd = (L & 255) >> 5, w = L & 31, i = L >> 8; att::attn_unit<false>(T, xcd, 2 * i + (w >> 4), w & 15, (char*)lds + RING_OFF); }
        if ((MK_PHASE_MASK >> 12) & 1) for (int L = F.vcu; L < nU; L += F.G) { const int xcd = (L & 255) >> 5, w = L & 31, i = L >> 8; att::attn_unit<true>(T, xcd, 2 * i + (w >> 4), w & 15, (char*)lds + RING_OFF); }
    } SEAM(4);
    if (((MK_PHASE_MASK >> 5) & 1) && IN(5)) {
        SchedDense S{MX / 256, 4, F.G, (int)blockIdx.x}; EpiMerge E{(bf16_t*)(ws + WS_T), (const bf16_t*)(ws + WS_GATES)};
        pg8::gemm_phase<EpiMerge, SchedDense, true>(F.lds + RING_OFF, (const bf16_t*)F.out, (const bf16_t*)(ws + WS_WPROJ), 1024, S, E);
    } SEAM(5);
    if (((MK_PHASE_MASK >> 6) & 1) && IN(6)) {
        SchedDense S{MX / 256, 4, F.G, (int)blockIdx.x}; EpiOut E{(bf16_t*)(ws + WS_MIXR)};
        pg8::gemm_phase<EpiOut, SchedDense, true>(F.lds + RING_OFF, (const bf16_t*)(ws + WS_T), (const bf16_t*)(ws + WS_WOUT), 1024, S, E);
    } SEAM(6);
    if (((MK_PHASE_MASK >> 7) & 1) && IN(7)) { p7_ln_router(F); } SEAM(7);
    if (((MK_PHASE_MASK >> 8) & 1) && IN(8)) { p8_topk_gather(F); } SEAM(8);
    if (((MK_PHASE_MASK >> 9) & 1) && IN(9)) {
        SchedExpert<8> S{F.vcu}; EpiSwiGLU E{(bf16_t*)(ws + WS_H)};
        pg8::gemm_phase<EpiSwiGLU, SchedExpert<8>, true, true>(F.lds + RING_OFF, (const bf16_t*)(ws + WS_U2), (const bf16_t*)(ws + WS_WGU), 1024, S, E, (const int*)(ws + WS_IDX));
    } SEAM(9);
    if (((MK_PHASE_MASK >> 10) & 1) && IN(10)) {
        SchedExpert<4> S{F.vcu}; EpiDown E{(bf16_t*)(ws + WS_YE), (const float*)(ws + WS_GV)};
        pg8::gemm_phase<EpiDown, SchedExpert<4>, true>(F.lds + RING_OFF, (const bf16_t*)(ws + WS_H), (const bf16_t*)(ws + WS_WD), 1024, S, E);
    } SEAM(10);
    if (((MK_PHASE_MASK >> 11) & 1) && IN(11)) { p11_final(F); }
#undef IN
#undef SEAM
}

#ifndef MK_CHECK
#define MK_CHECK 0
#endif
#if MK_CHECK
constexpr size_t WS_ERR = 900 * 1024;
constexpr size_t WS_STASH = WS_B + 100 * MiB;
__device__ __forceinline__ void err_acc(float* ERR, int stage, float num, float den) {
    __shared__ float rn[256], rd[256];
    const int tid = threadIdx.x; rn[tid] = num; rd[tid] = den; __syncthreads();
    for (int o = 128; o > 0; o >>= 1) { if (tid < o) { rn[tid] += rn[tid + o]; rd[tid] += rd[tid + o]; } __syncthreads(); }
    if (tid == 0) { atomicAdd(ERR + 2 * stage, rn[0]); atomicAdd(ERR + 2 * stage + 1, rd[0]); }
    __syncthreads();
}
#define SQ(x) ((x) * (x))
__device__ __forceinline__ float silu_ref(float v) { return v / (1.f + expf(-v)); }
__device__ __forceinline__ int sample_xrow(int i) { const int edge[8] = {0, 63, 64, 4032, 4095, 2048, 255, 256}; return (i < 64) ? ((i >> 3) * SEQ + edge[i & 7]) : (int)(((long)i * 7919 + 13) % MX); }
__device__ __forceinline__ int rope_slot(int d) { return d < 16 ? 2 * d : 2 * (d - 16) + 1; }
__device__ __forceinline__ void rope_ref(const float* in32, float* out32, int t) {
    for (int i = 0; i < 16; ++i) { const float pos = (i < 8) ? (float)(t / 64) : (float)(t % 64); const float inv = powf(10000.f, -(float)(2 * (i & 7)) / 16.f), ang = pos * inv, cs = cosf(ang), sn = sinf(ang);
        out32[i] = in32[i] * cs - in32[16 + i] * sn; out32[16 + i] = in32[i] * sn + in32[16 + i] * cs; }
}
__global__ void chk_mod(const float* c, const float* cctx, const float* wmod, const float* bmod, const float* MOD, float* ERR) {
    const int r = blockIdx.y, n = blockIdx.x * 256 + threadIdx.x; const float* cv = r < 8 ? c + r * 1024 : cctx;
    float a = bmod[n]; for (int k = 0; k < 1024; ++k) a += silu_ref(cv[k]) * wmod[(size_t)k * 6144 + n];
    err_acc(ERR, 0, SQ(MOD[r * 6144 + n] - a), SQ(a));
}
__global__ void chk_u(const float* x, const float* ctx, const float* MOD, const bf16_t* U, float* ERR) {
    const int i = blockIdx.x; const int m = (i < 16) ? ((i >> 1) * SCOMB + ((i & 1) ? 255 : 0)) : (int)(((long)i * 104729 + 7) % MC);
    const int b = m / SCOMB, j = m % SCOMB; const float* src = j < CTXL ? ctx + ((size_t)b * CTXL + j) * DM : x + ((size_t)b * SEQ + j - CTXL) * DM; const float* mr = MOD + (j < CTXL ? 8 : b) * 6144;
    __shared__ float red[256]; const int tid = threadIdx.x;
    float s = 0; for (int k = tid; k < 1024; k += 256) s += src[k]; red[tid] = s; __syncthreads(); for (int o = 128; o > 0; o >>= 1) { if (tid < o) red[tid] += red[tid + o]; __syncthreads(); } const float mean = red[0] / 1024.f; __syncthreads();
    s = 0; for (int k = tid; k < 1024; k += 256) s += SQ(src[k] - mean); red[tid] = s; __syncthreads(); for (int o = 128; o > 0; o >>= 1) { if (tid < o) red[tid] += red[tid + o]; __syncthreads(); } const float rstd = 1.f / sqrtf(red[0] / 1024.f + LN_EPS); __syncthreads();
    float num = 0, den = 0; for (int k = tid; k < 1024; k += 256) { const float y = (src[k] - mean) * rstd * (1.f + mr[1024 + k]) + mr[k]; num += SQ(bf2f(U[(size_t)m * 1024 + k]) - y); den += SQ(y); }
    err_acc(ERR, 1, num, den);
}
__global__ void chk_inproj(const bf16_t* U, const float* win, const unsigned char* ws, float* ERR) {
    const int i = blockIdx.x; const int m = (i < 16) ? ((i >> 1) * SCOMB + ((i & 1) ? 255 : 17)) : ((i < 32) ? ((i - 16) >> 1) * SCOMB + 256 + (((i & 1) ? 4095 : 64)) : (int)(((long)i * 104729 + 7) % MC));
    const int b = m / SCOMB, j = m % SCOMB, tid = threadIdx.x; const bool isx = j >= CTXL; const int t = j - CTXL; const size_t xrow = (size_t)b * SEQ + t;
    __shared__ float u[1024]; __shared__ float p[4000];
    for (int k = tid; k < 1024; k += 256) u[k] = bf2f(U[(size_t)m * 1024 + k]); __syncthreads();
    for (int n = tid; n < 4000; n += 256) { float a = 0; for (int k = 0; k < 1024; ++k) a += u[k] * win[(size_t)k * 4000 + n]; p[n] = a; } __syncthreads();
    const bf16_t *QC = (const bf16_t*)(ws + WS_QC), *KVX = (const bf16_t*)(ws + WS_KVX), *NQ = (const bf16_t*)(ws + WS_NQ), *NK = (const bf16_t*)(ws + WS_NK), *NV = (const bf16_t*)(ws + WS_NV), *GT = (const bf16_t*)(ws + WS_GATES);
    const float* ssq_kv = (const float*)(ws + WS_SSQ); const float* ssq_q = ssq_kv + MC;
    float num = 0, den = 0;
    for (int n = tid; n < 4000; n += 256) { float ref = p[n], fast; bool use = true;
        if (n < 256) { use = isx; fast = use ? bf2f(QC[xrow * 256 + n]) : 0.f; }
        else if (n < 384) fast = bf2f(KVX[(size_t)m * 256 + n - 256]);
        else if (n < 416) { const int d = n - 384; if (isx) { float o32[32]; rope_ref(p + 384, o32, t); ref = o32[d]; } fast = bf2f(KVX[(size_t)m * 256 + 128 + rope_slot(d)]); }
        else if (n < 928) { use = isx; ref *= NA_QS; fast = use ? bf2f(NQ[xrow * 512 + n - 416]) : 0.f; }
        else if (n < 1440) fast = bf2f(NK[(size_t)m * 512 + n - 928]);
        else if (n < 1952) fast = bf2f(NV[(size_t)m * 512 + n - 1440]);
        else { use = isx; ref = 1.f / (1.f + expf(-ref)); fast = use ? bf2f(GT[xrow * 2048 + n - 1952]) : 0.f; }
        if (use) { num += SQ(fast - ref); den += SQ(ref); } }
    if (tid == 0) { float s = 0; for (int n = 256; n < 384; ++n) s += SQ(p[n]); num += SQ(ssq_kv[m] - s); den += SQ(s);
        if (isx) { s = 0; for (int n = 0; n < 256; ++n) s += SQ(p[n]); num += SQ(ssq_q[xrow] - s); den += SQ(s); } }
    err_acc(ERR, 2, num, den);
}
__global__ void chk_up(const float* qg, const float* wuq, const float* kvg, const float* wukv, const unsigned char* ws, float* ERR) {
    const int i = blockIdx.x, tid = threadIdx.x; const int xr = sample_xrow(i), b = xr / SEQ, t = xr % SEQ; const size_t m = (i & 1) ? (size_t)b * SCOMB + (t & 255) : (size_t)b * SCOMB + CTXL + t;
    const bf16_t *QC = (const bf16_t*)(ws + WS_QC), *KVX = (const bf16_t*)(ws + WS_KVX), *QM = (const bf16_t*)(ws + WS_QM), *KMN = (const bf16_t*)(ws + WS_KMN), *VM = (const bf16_t*)(ws + WS_VM);
    __shared__ float qn[256], kn[128], q[768];
    { float s = 0; for (int k = 0; k < 256; ++k) s += SQ(bf2f(QC[(size_t)xr * 256 + k])); const float rs = 1.f / sqrtf(s / 256.f + RMS_EPS); qn[tid] = bf2f(QC[(size_t)xr * 256 + tid]) * rs * qg[tid]; }
    if (tid < 128) { float s = 0; for (int k = 0; k < 128; ++k) s += SQ(bf2f(KVX[m * 256 + k])); const float rs = 1.f / sqrtf(s / 128.f + RMS_EPS); kn[tid] = bf2f(KVX[m * 256 + tid]) * rs * kvg[tid]; }
    __syncthreads();
    for (int n = tid; n < 768; n += 256) { float a = 0; for (int k = 0; k < 256; ++k) a += qn[k] * wuq[(size_t)k * 768 + n]; q[n] = a; } __syncthreads();
    float num = 0, den = 0;
    for (int n = tid; n < 768; n += 256) { const int h = n / 96, d = n % 96; float ref; int col;
        if (d < 64) { ref = q[n]; col = n; } else { float o32[32]; rope_ref(q + h * 96 + 64, o32, t); ref = o32[d - 64]; col = h * 96 + 64 + rope_slot(d - 64); }
        ref *= MLA_QS; const float fast = bf2f(QM[(size_t)xr * 768 + col]); num += SQ(fast - ref); den += SQ(ref); }
    for (int n = tid; n < 1024; n += 256) { float a = 0; for (int k = 0; k < 128; ++k) a += kn[k] * wukv[(size_t)k * 1024 + n]; const int h = n >> 7, d = n & 127;
        const float fast = d < 64 ? bf2f(KMN[m * 512 + h * 64 + d]) : bf2f(VM[m * 512 + h * 64 + d - 64]); num += SQ(fast - a); den += SQ(a); }
    err_acc(ERR, 3, num, den);
}
__global__ void chk_attn(const float* rel_bias, const unsigned char* ws, const bf16_t* Y, float* ERR) {
    const int pr[12] = {0, 0, 63, 63, 3, 4, 31, 59, 60, 5, 32, 17}, pc[12] = {0, 63, 0, 63, 7, 8, 31, 55, 56, 40, 3, 60};
    const int si = blockIdx.x, h = blockIdx.y, kind = blockIdx.z, b = si / 12, r = pr[si % 12], c = pc[si % 12], t = r * 64 + c, tid = threadIdx.x;
    const size_t xr = (size_t)b * SEQ + t, kb = (size_t)b * SCOMB;
    const bf16_t *QM = (const bf16_t*)(ws + WS_QM), *KMN = (const bf16_t*)(ws + WS_KMN), *KVX = (const bf16_t*)(ws + WS_KVX), *VM = (const bf16_t*)(ws + WS_VM), *NQ = (const bf16_t*)(ws + WS_NQ), *NK = (const bf16_t*)(ws + WS_NK), *NV = (const bf16_t*)(ws + WS_NV);
    __shared__ float sc[SCOMB]; __shared__ int krow[SCOMB]; __shared__ float red[256]; __shared__ float ov[4][64];
    int nk;
    if (kind == 0) { nk = SCOMB; for (int k = tid; k < nk; k += 256) { float a = 0; for (int d = 0; d < 64; ++d) a += bf2f(QM[xr * 768 + h * 96 + d]) * bf2f(KMN[(kb + k) * 512 + h * 64 + d]);
            for (int d = 0; d < 32; ++d) a += bf2f(QM[xr * 768 + h * 96 + 64 + d]) * bf2f(KVX[(kb + k) * 256 + 128 + d]); sc[k] = a; krow[k] = k; } }
    else { nk = 384; const int r0 = min(max(r - 4, 0), 56), c0 = min(max(c - 8, 0), 48);
        for (int k = tid; k < nk; k += 256) { int row; float bias = 0.f; if (k < 256) row = k; else { const int w = k - 256, rr = r0 + (w >> 4), kc = c0 + (w & 15); row = 256 + rr * 64 + kc; bias = rel_bias[(h * 15 + rr - r + 7) * 31 + kc - c + 15] * LOG2E; }
            float a = 0; for (int d = 0; d < 64; ++d) a += bf2f(NQ[xr * 512 + h * 64 + d]) * bf2f(NK[(kb + row) * 512 + h * 64 + d]); sc[k] = a + bias; krow[k] = row; } }
    __syncthreads();
    float mx = -1e30f; for (int k = tid; k < nk; k += 256) mx = fmaxf(mx, sc[k]); red[tid] = mx; __syncthreads(); for (int o = 128; o > 0; o >>= 1) { if (tid < o) red[tid] = fmaxf(red[tid], red[tid + o]); __syncthreads(); } mx = red[0]; __syncthreads();
    float sm = 0; for (int k = tid; k < nk; k += 256) { const float p = exp2f(sc[k] - mx); sc[k] = p; sm += p; } red[tid] = sm; __syncthreads(); for (int o = 128; o > 0; o >>= 1) { if (tid < o) red[tid] += red[tid + o]; __syncthreads(); } sm = red[0]; __syncthreads();
    const bf16_t* V = kind == 0 ? VM : NV; const int d = tid & 63, part = tid >> 6; float a = 0; for (int k = part; k < nk; k += 4) a += sc[k] * bf2f(V[(kb + krow[k]) * 512 + h * 64 + d]); ov[part][d] = a; __syncthreads();
    float num = 0, den = 0; if (tid < 64) { const float ref = (ov[0][tid] + ov[1][tid] + ov[2][tid] + ov[3][tid]) / sm; const float fast = bf2f(Y[xr * 1024 + kind * 512 + h * 64 + tid]); num = SQ(fast - ref); den = SQ(ref); }
    err_acc(ERR, 4 + kind * 8, num, den);
}
#define ROWDOT(acc, xin, K, W, ldw, n) do { acc = 0.f; for (int k_ = 0; k_ < (K); ++k_) acc += (xin)[k_] * (W)[(size_t)k_ * (ldw) + (n)]; } while (0)
__global__ void chk_merge(const float* wpm, const float* wpn, const unsigned char* ws, const bf16_t* Y, float* ERR) {
    const int xr = sample_xrow(blockIdx.x), tid = threadIdx.x; const bf16_t *GT = (const bf16_t*)(ws + WS_GATES), *T = (const bf16_t*)(ws + WS_T);
    __shared__ float y[1024]; for (int k = tid; k < 1024; k += 256) y[k] = bf2f(Y[(size_t)xr * 1024 + k]); __syncthreads();
    float num = 0, den = 0;
    for (int n = tid; n < 1024; n += 256) { float a, c; ROWDOT(a, y, 512, wpm, 1024, n); ROWDOT(c, y + 512, 512, wpn, 1024, n);
        const float ref = bf2f(GT[(size_t)xr * 2048 + n]) * a + bf2f(GT[(size_t)xr * 2048 + 1024 + n]) * c; num += SQ(bf2f(T[(size_t)xr * 1024 + n]) - ref); den += SQ(ref); }
    err_acc(ERR, 5, num, den);
}
__global__ void chk_out(const float* x, const float* wout, const float* MOD, const float* ln1g, const float* ln1b, const float* wr, const unsigned char* ws, const float* V, float* stash, float* ERR) {
    const int xr = sample_xrow(blockIdx.x), b = xr / SEQ, tid = threadIdx.x; const bf16_t* T = (const bf16_t*)(ws + WS_T); const bf16_t* MR = (const bf16_t*)(ws + WS_MIXR);
    __shared__ float tv[1024], x1[1024], u2[1024], red[256], vv[1024]; for (int k = tid; k < 1024; k += 256) tv[k] = bf2f(T[(size_t)xr * 1024 + k]); __syncthreads();
    float num = 0, den = 0;
    for (int n = tid; n < 1024; n += 256) { float a; ROWDOT(a, tv, 1024, wout, 1024, n); const float fast = bf2f(MR[(size_t)xr * 1024 + n]); num += SQ(fast - a); den += SQ(a); }
    err_acc(ERR, 6, num, den);
    for (int k = tid; k < 1024; k += 256) vv[k] = ALPHA * x[(size_t)xr * 1024 + k] + MOD[b * 6144 + 2048 + k] * bf2f(MR[(size_t)xr * 1024 + k]); __syncthreads();
    float s = 0; for (int k = tid; k < 1024; k += 256) s += vv[k]; red[tid] = s; __syncthreads(); for (int o = 128; o > 0; o >>= 1) { if (tid < o) red[tid] += red[tid + o]; __syncthreads(); } float mean = red[0] / 1024.f; __syncthreads();
    s = 0; for (int k = tid; k < 1024; k += 256) s += SQ(vv[k] - mean); red[tid] = s; __syncthreads(); for (int o = 128; o > 0; o >>= 1) { if (tid < o) red[tid] += red[tid + o]; __syncthreads(); } float rstd = 1.f / sqrtf(red[0] / 1024.f + LN_EPS); __syncthreads();
    for (int k = tid; k < 1024; k += 256) x1[k] = (vv[k] - mean) * rstd * ln1g[k] + ln1b[k]; __syncthreads();
    s = 0; for (int k = tid; k < 1024; k += 256) s += x1[k]; red[tid] = s; __syncthreads(); for (int o = 128; o > 0; o >>= 1) { if (tid < o) red[tid] += red[tid + o]; __syncthreads(); } mean = red[0] / 1024.f; __syncthreads();
    s = 0; for (int k = tid; k < 1024; k += 256) s += SQ(x1[k] - mean); red[tid] = s; __syncthreads(); for (int o = 128; o > 0; o >>= 1) { if (tid < o) red[tid] += red[tid + o]; __syncthreads(); } rstd = 1.f / sqrtf(red[0] / 1024.f + LN_EPS); __syncthreads();
    for (int k = tid; k < 1024; k += 256) u2[k] = (x1[k] - mean) * rstd * (1.f + MOD[b * 6144 + 4096 + k]) + MOD[b * 6144 + 3072 + k]; __syncthreads();
    float* st = stash + (size_t)blockIdx.x * 2304;
    for (int k = tid; k < 1024; k += 256) { st[k] = x1[k]; st[1024 + k] = u2[k]; }
    if (tid < 16) { float a; ROWDOT(a, u2, 1024, wr, 16, tid); red[tid] = a; } __syncthreads();
    if (tid < 16) { float mx = -1e30f; for (int e = 0; e < 16; ++e) mx = fmaxf(mx, red[e]); float sm = 0; for (int e = 0; e < 16; ++e) sm += expf(red[e] - mx); st[2048 + tid] = expf(red[tid] - mx) / sm; }
}
__global__ void chk_p7(const unsigned char* ws, const float*  , const float* stash, float* ERR) {
    const int xr = sample_xrow(blockIdx.x), tid = threadIdx.x; const float* st = stash + (size_t)blockIdx.x * 2304; const bf16_t* U2 = (const bf16_t*)(ws + WS_U2); const float* AFF = (const float*)(ws + WS_AFF);
    float num = 0, den = 0;
    for (int k = tid; k < 1024; k += 256) { num += SQ(bf2f(U2[(size_t)xr * 1024 + k]) - st[1024 + k]); den += SQ(st[1024 + k]); }
    err_acc(ERR, 7, num, den);
    num = 0; den = 0; if (tid < 16) { num = SQ(AFF[(size_t)xr * 16 + tid] - st[2048 + tid]); den = SQ(st[2048 + tid]); }
    err_acc(ERR, 13, num, den);
}
__global__ void chk_topk(const unsigned char* ws, float* ERR) {
    const int tk = blockIdx.x, e = tk >> 3, b = tk & 7, tid = threadIdx.x; const float* AFF = (const float*)(ws + WS_AFF); const int* INV = (const int*)(ws + WS_INV); const float* GV = (const float*)(ws + WS_GV);
    const int* IDX = (const int*)(ws + WS_IDX);
    __shared__ float rmin[256], rmax[256]; __shared__ int rc[256];
    float mn = 1e30f, mx = -1e30f; int cnt = 0; float bad = 0;
    for (int t = tid; t < SEQ; t += 256) { const int sl = INV[((size_t)b * SEQ + t) * 16 + e]; const float a = AFF[((size_t)b * SEQ + t) * 16 + e];
        if (sl >= 0) { mn = fminf(mn, a); ++cnt; if (sl >= CAP) bad += 1; else { if (GV[(size_t)tk * CAP + sl] != a) bad += 1; if (IDX[(size_t)tk * CAP + sl] != b * SEQ + t) bad += 1; } }
        else mx = fmaxf(mx, a); }
    rmin[tid] = mn; rmax[tid] = mx; rc[tid] = cnt; __syncthreads();
    for (int o = 128; o > 0; o >>= 1) { if (tid < o) { rmin[tid] = fminf(rmin[tid], rmin[tid + o]); rmax[tid] = fmaxf(rmax[tid], rmax[tid + o]); rc[tid] += rc[tid + o]; } __syncthreads(); }
    if (tid == 0) { if (rc[0] != CAP) bad += 100; if (rmin[0] < rmax[0]) bad += 100; }
    err_acc(ERR, 8, bad, tid == 0 ? 1.f / 128.f : 0.f);
}
__global__ void chk_exp_up(const float* weg, const float* weu, const unsigned char* ws, float* ERR) {
    const int row = (int)(((long)blockIdx.x * 104729 + 511) % ME), e = row / (CAP * 8), tid = threadIdx.x; const bf16_t *U2 = (const bf16_t*)(ws + WS_U2), *H = (const bf16_t*)(ws + WS_H); const int* IDX = (const int*)(ws + WS_IDX);
    __shared__ float xe[1024]; for (int k = tid; k < 1024; k += 256) xe[k] = bf2f(U2[(size_t)IDX[row] * 1024 + k]); __syncthreads();
    float num = 0, den = 0; const float* wg = weg + (size_t)e * 1024 * 1024; const float* wu = weu + (size_t)e * 1024 * 1024;
    for (int n = tid; n < 1024; n += 256) { float g, u; ROWDOT(g, xe, 1024, wg, 1024, n); ROWDOT(u, xe, 1024, wu, 1024, n); const float ref = silu_ref(g) * u; num += SQ(bf2f(H[(size_t)row * 1024 + n]) - ref); den += SQ(ref); }
    err_acc(ERR, 9, num, den);
}
__global__ void chk_exp_down(const float* wed, const unsigned char* ws, float* ERR) {
    const int row = (int)(((long)blockIdx.x * 104729 + 511) % ME), e = row / (CAP * 8), tid = threadIdx.x; const bf16_t *H = (const bf16_t*)(ws + WS_H), *YE = (const bf16_t*)(ws + WS_YE); const float* GV = (const float*)(ws + WS_GV);
    __shared__ float hv[1024]; for (int k = tid; k < 1024; k += 256) hv[k] = bf2f(H[(size_t)row * 1024 + k]); __syncthreads();
    float num = 0, den = 0; const float* wd = wed + (size_t)e * 1024 * 1024;
    for (int n = tid; n < 1024; n += 256) { float a; ROWDOT(a, hv, 1024, wd, 1024, n); const float ref = a * GV[row]; num += SQ(bf2f(YE[(size_t)row * 1024 + n]) - ref); den += SQ(ref); }
    err_acc(ERR, 10, num, den);
}
__global__ void chk_final_pre(const float* MOD, const float* ln2g, const float* ln2b, const unsigned char* ws, const float* x, const float* ln1g, const float* ln1b, float* stash) {
    const int xr = sample_xrow(blockIdx.x), b = xr / SEQ, t = xr % SEQ, tid = threadIdx.x; const bf16_t* YE = (const bf16_t*)(ws + WS_YE); const int* INV = (const int*)(ws + WS_INV); const bf16_t* MR = (const bf16_t*)(ws + WS_MIXR);
    __shared__ float v[1024], red[256];
    for (int k = tid; k < 1024; k += 256) v[k] = ALPHA * x[(size_t)xr * 1024 + k] + MOD[b * 6144 + 2048 + k] * bf2f(MR[(size_t)xr * 1024 + k]); __syncthreads();
    float s = 0; for (int k = tid; k < 1024; k += 256) s += v[k]; red[tid] = s; __syncthreads(); for (int o = 128; o > 0; o >>= 1) { if (tid < o) red[tid] += red[tid + o]; __syncthreads(); } float mean = red[0] / 1024.f; __syncthreads();
    s = 0; for (int k = tid; k < 1024; k += 256) s += SQ(v[k] - mean); red[tid] = s; __syncthreads(); for (int o = 128; o > 0; o >>= 1) { if (tid < o) red[tid] += red[tid + o]; __syncthreads(); } float rstd = 1.f / sqrtf(red[0] / 1024.f + LN_EPS); __syncthreads();
    for (int k = tid; k < 1024; k += 256) { const float x1 = (v[k] - mean) * rstd * ln1g[k] + ln1b[k]; float mo = 0; for (int e = 0; e < 16; ++e) { const int sl = INV[((size_t)b * SEQ + t) * 16 + e]; if (sl >= 0) mo += bf2f(YE[((size_t)(e * 8 + b) * CAP + sl) * 1024 + k]); }
        v[k] = ALPHA * x1 + MOD[b * 6144 + 5120 + k] * mo; } __syncthreads();
    s = 0; for (int k = tid; k < 1024; k += 256) s += v[k]; red[tid] = s; __syncthreads(); for (int o = 128; o > 0; o >>= 1) { if (tid < o) red[tid] += red[tid + o]; __syncthreads(); } mean = red[0] / 1024.f; __syncthreads();
    s = 0; for (int k = tid; k < 1024; k += 256) s += SQ(v[k] - mean); red[tid] = s; __syncthreads(); for (int o = 128; o > 0; o >>= 1) { if (tid < o) red[tid] += red[tid + o]; __syncthreads(); } rstd = 1.f / sqrtf(red[0] / 1024.f + LN_EPS);
    for (int k = tid; k < 1024; k += 256) stash[(size_t)blockIdx.x * 1024 + k] = (v[k] - mean) * rstd * ln2g[k] + ln2b[k];
}
__global__ void chk_final_post(const float* out, const float* stash, float* ERR) {
    const int xr = sample_xrow(blockIdx.x), tid = threadIdx.x; float num = 0, den = 0;
    for (int k = tid; k < 1024; k += 256) { num += SQ(out[(size_t)xr * 1024 + k] - stash[(size_t)blockIdx.x * 1024 + k]); den += SQ(stash[(size_t)blockIdx.x * 1024 + k]); }
    err_acc(ERR, 11, num, den);
}
__global__ void chk_scale(float* out, const float* ERR, unsigned mask, float gain) {
    float e = 0; for (int p = 0; p < 16; ++p) if ((mask >> p) & 1u) e += ERR[2 * p] / fmaxf(ERR[2 * p + 1], 1e-30f);
    const float f = 1.f + sqrtf(e * gain);
    for (size_t i = (size_t)blockIdx.x * 256 + threadIdx.x; i < (size_t)MX * DM; i += (size_t)gridDim.x * 256) out[i] *= f;
}
#endif

extern "C" void kernel_launch(void* const* d_in, const int* in_sizes, int n_in, void* d_out, int out_size, void* d_ws, size_t ws_size, hipStream_t stream) {
    static int grid = 0;
    if (grid == 0) {
        if (n_in != 23 || in_sizes[0] != MX * DM || out_size != MX * DM || ws_size < WS_END) {
            fprintf(stderr, "kernel_launch: shape mismatch: n_in %d in0 %d out %d ws %zu (need >= %zu)\n", n_in, n_in > 0 ? in_sizes[0] : -1, out_size, ws_size, (size_t)WS_END); grid = -1; return; }
        int dev = 0, cus = 0, per_cu = 0;
        if (hipGetDevice(&dev) != hipSuccess || hipDeviceGetAttribute(&cus, hipDeviceAttributeMultiprocessorCount, dev) != hipSuccess) { fprintf(stderr, "kernel_launch: device query failed\n"); grid = -1; return; }
        if (hipFuncSetAttribute((const void*)fwd_mega, hipFuncAttributeMaxDynamicSharedMemorySize, LDS_BYTES) != hipSuccess) { fprintf(stderr, "kernel_launch: hipFuncSetAttribute failed\n"); grid = -1; return; }
        if (hipOccupancyMaxActiveBlocksPerMultiprocessor(&per_cu, (const void*)fwd_mega, NWAVES * 64, LDS_BYTES) != hipSuccess || per_cu < 1) { fprintf(stderr, "kernel_launch: occupancy query reports %d blocks per CU\n", per_cu); (void)hipGetLastError(); grid = -1; return; }
        grid = cus;
        if (grid != 256) { fprintf(stderr, "kernel_launch: this kernel's unit orders are built for 256 CUs, found %d\n", cus); grid = -1; return; }
    }
    if (grid < 0) return;
    (void)hipMemsetAsync((char*)d_ws + WS_CTL, 0, CTL_ZERO_BYTES, stream);
    Args a{};
    for (int i = 0; i < 23; ++i) a.in[i] = (const float*)d_in[i];
    a.out = (float*)d_out; a.ws = (unsigned char*)d_ws;
#if MK_CHECK
    {
        const unsigned char* ws = (const unsigned char*)d_ws; float* ERR = (float*)((char*)d_ws + WS_ERR); const float* MOD = (const float*)((char*)d_ws + WS_MOD);
        float* stash = (float*)((char*)d_ws + WS_STASH); float* stash2 = (float*)((char*)d_ws + WS_C + 64 * MiB); const float* const* in = (const float* const*)a.in; float* out = (float*)d_out;
        constexpr int NS = 192;
        for (int p = 0; p < N_PHASES; ++p) {
            if (p == 11) chk_final_pre<<<NS, 256, 0, stream>>>(MOD, in[I_LN2G], in[I_LN2B], ws, in[I_X], in[I_LN1G], in[I_LN1B], stash2);
            a.ph_lo = p; a.ph_hi = p + 1; hipLaunchKernelGGL(fwd_mega, dim3(grid), dim3(NWAVES * 64), LDS_BYTES, stream, a);
            switch (p) {
            case 0: chk_mod<<<dim3(24, 9), 256, 0, stream>>>(in[I_C], in[I_CCTX], in[I_WMOD], in[I_BMOD], MOD, ERR); break;
            case 1: chk_u<<<NS, 256, 0, stream>>>(in[I_X], in[I_CTX], MOD, (const bf16_t*)(ws + WS_U), ERR); break;
            case 2: chk_inproj<<<96, 256, 0, stream>>>((const bf16_t*)(ws + WS_U), in[I_WIN], ws, ERR); break;
            case 3: chk_up<<<NS, 256, 0, stream>>>(in[I_QG], in[I_WUQ], in[I_KVG], in[I_WUKV], ws, ERR); break;
            case 4: chk_attn<<<dim3(96, 8, 2), 256, 0, stream>>>(in[I_BIAS], ws, (const bf16_t*)out, ERR); break;
            case 5: chk_merge<<<NS, 256, 0, stream>>>(in[I_WPM], in[I_WPN], ws, (const bf16_t*)out, ERR); break;
            case 6: chk_out<<<NS, 256, 0, stream>>>(in[I_X], in[I_WOUT], MOD, in[I_LN1G], in[I_LN1B], in[I_WR], ws, out, stash, ERR); break;
            case 7: chk_p7<<<NS, 256, 0, stream>>>(ws, out, stash, ERR); break;
            case 8: chk_topk<<<128, 256, 0, stream>>>(ws, ERR); break;
            case 9: chk_exp_up<<<NS, 256, 0, stream>>>(in[I_WEG], in[I_WEU], ws, ERR); break;
            case 10: chk_exp_down<<<NS, 256, 0, stream>>>(in[I_WED], ws, ERR); break;
            case 11: chk_final_post<<<NS, 256, 0, stream>>>(out, stash2, ERR); break;
            }
        }
        chk_scale<<<1024, 256, 0, stream>>>(out, ERR, (unsigned)(MK_CHECK), 1.0f);
    }
#elif MK_N_LAUNCHES == 1
    a.ph_lo = 0; a.ph_hi = N_PHASES;
    void* kargs[] = {&a};
    hipError_t le = hipLaunchCooperativeKernel((const void*)fwd_mega, dim3(grid), dim3(NWAVES * 64), kargs, LDS_BYTES, stream);
    if (le != hipSuccess) fprintf(stderr, "kernel_launch: cooperative launch failed: %s\n", hipGetErrorName(le));
#else
    for (int p = 0; p < N_PHASES; ++p) for (int r = 0; r < 1 + ((MK_REPEAT >> p) & 1); ++r) { a.ph_lo = p; a.ph_hi = p + 1; a.rep = r; hipLaunchKernelGGL(fwd_mega, dim3(grid), dim3(NWAVES * 64), LDS_BYTES, stream, a); }
#endif
}
```

```cpp
#include <hip/hip_runtime.h>
#include <hip/hip_bf16.h>
#include <hip/hip_cooperative_groups.h>
#include <cstdio>
#include <cstdint>
#include <cmath>

#ifndef MK_N_LAUNCHES
#define MK_N_LAUNCHES 1
#endif
#ifndef MK_PHASE_MASK
#define MK_PHASE_MASK 0x3FFF
#endif
#ifndef MK_REPEAT
#define MK_REPEAT 0
#endif
#ifndef MK_DEBUG
#define MK_DEBUG 0
#endif

#define LAS __attribute__((address_space(3)))
#define GAS __attribute__((address_space(1)))
typedef unsigned short bf16_t;
typedef short bf16x8 __attribute__((ext_vector_type(8)));
typedef short s16x4 __attribute__((ext_vector_type(4)));
typedef float f32x4 __attribute__((ext_vector_type(4)));
typedef float f32x2 __attribute__((ext_vector_type(2)));
typedef float f32x16 __attribute__((ext_vector_type(16)));
typedef unsigned u32x4 __attribute__((ext_vector_type(4)));
typedef unsigned u32x2 __attribute__((ext_vector_type(2)));
typedef _Float16 h16x2 __attribute__((ext_vector_type(2)));
typedef __bf16 bf16x2_t __attribute__((ext_vector_type(2)));

constexpr int DM = 1024, NBATCH = 8, SEQ = 4096, CTXL = 256, SCOMB = SEQ + CTXL;
constexpr int MX = NBATCH * SEQ;
constexpr int MC = NBATCH * SCOMB;
constexpr int NEXP = 16, CAP = 512, ME = NBATCH * NEXP * CAP;
constexpr int D_IN = 4000;
constexpr float LOG2E = 1.4426950408889634f;
constexpr float LN2_F = 0.6931471805599453f;
constexpr float MLA_QS = 0.10206207261596575f * LOG2E;
constexpr float NA_QS = 0.125f * LOG2E;
constexpr float ALPHA = 1.189207115002721f;
constexpr float LN_EPS = 1e-5f, RMS_EPS = 1e-6f;

__device__ __forceinline__ unsigned cvtpk(float lo, float hi) { f32x2 v = {lo, hi}; bf16x2_t b = __builtin_convertvector(v, bf16x2_t); return __builtin_bit_cast(unsigned, b); }
__device__ __forceinline__ float bf2f(unsigned short h) { return __uint_as_float((unsigned)h << 16); }
__device__ __forceinline__ float bflo(unsigned w) { return __uint_as_float(w << 16); }
__device__ __forceinline__ float bfhi(unsigned w) { return __uint_as_float(w & 0xffff0000u); }

namespace pg8 {
constexpr int BM = 256, BK = 64, HALF = 128, HTB = HALF * BK * 2, STAGE_BYTES = 8 * HTB;
__host__ __device__ __forceinline__ int lds_byte(int r, int c) { const int st = (r >> 4) * 2 + (c >> 5), rr = r & 15, cc = c & 31, ob = rr * 64 + cc * 2; return st * 1024 + (ob ^ (((ob >> 9) & 1) << 5)); }
__host__ __device__ __forceinline__ void stage_rc(int b, int& R, int& C) { const int st = b / 1024, sb = b % 1024, swz = sb ^ (((sb >> 9) & 1) << 5); R = (st >> 1) * 16 + swz / 64; C = (st & 1) * 32 + (swz % 64) / 2; }
__host__ __device__ __forceinline__ int perm32(int rho) { const int n = rho >> 4, i = rho & 15; return 8 * (i >> 2) + 4 * n + (i & 3); }

struct Unit { int pm, pn, pb; };

template <class Epi, class Sched, bool ALIGN_EPI, bool GATHER = false>
__device__ __forceinline__ void gemm_phase(LAS unsigned char* lds, const bf16_t* Ag, const bf16_t* Btg, const int K, const Sched& S, const Epi& E, const int* gidx = nullptr) {
    const int tid = threadIdx.x, wid = __builtin_amdgcn_readfirstlane(tid >> 6), lane = tid & 63, wr = wid >> 2, wc = wid & 3, fr = lane & 15, fq = lane >> 4;
    const int nt = K / BK;
    unsigned voffA[2], voffB[2];
#pragma unroll
    for (int i = 0; i < 2; ++i) { int R, C; stage_rc(tid * 16 + i * 8192, R, C); const int Rb = Epi::PERM ? ((R & ~31) + perm32(R & 31)) : R;
        voffA[i] = (unsigned)(R * K + C) * 2u; voffB[i] = (unsigned)(Rb * K + C) * 2u; }
    const size_t kstep = (size_t)(BK * 2);
    const size_t hstep = (size_t)HALF * K * 2;
    const size_t tstep = 2 * hstep;
    const unsigned ldsw = (unsigned)wid * 1024u;
    const int aoff = lds_byte(wr * 64 + fr, fq * 8), boff = lds_byte(wc * 32 + fr, fq * 8);
#define PG8_SA(b, h) (((b) * 2 + (h)) * HTB)
#define PG8_SB(b, h) ((4 + (b) * 2 + (h)) * HTB)
#define PG8_STAGE(bufoff, gbase, voff) do { _Pragma("unroll") for (int _i = 0; _i < 2; ++_i) \
        __builtin_amdgcn_global_load_lds((const unsigned*)((const char*)(gbase) + (voff)[_i]), (LAS unsigned*)(lds + (bufoff) + ldsw + _i * 8192), 16, 0, 0); } while (0)
#define PG8_LDA(dst, b, h) do { _Pragma("unroll") for (int m = 0; m < 4; ++m) _Pragma("unroll") for (int k = 0; k < 2; ++k) dst[m][k] = *(const LAS bf16x8*)(lds + PG8_SA(b, h) + aoff + m * 2048 + k * 1024); } while (0)
#define PG8_LDB(dst, b, h) do { _Pragma("unroll") for (int n = 0; n < 2; ++n) _Pragma("unroll") for (int k = 0; k < 2; ++k) dst[n][k] = *(const LAS bf16x8*)(lds + PG8_SB(b, h) + boff + n * 2048 + k * 1024); } while (0)
#define PG8_MMA(ai, bj, At, Bt) do { __builtin_amdgcn_s_setprio(1); _Pragma("unroll") for (int m = 0; m < 4; ++m) _Pragma("unroll") for (int n = 0; n < 2; ++n) _Pragma("unroll") for (int k = 0; k < 2; ++k) \
        acc[ai][bj][m][n] = __builtin_amdgcn_mfma_f32_16x16x32_bf16(Bt[n][k], At[m][k], acc[ai][bj][m][n], 0, 0, 0); __builtin_amdgcn_s_setprio(0); } while (0)
#define PG8_WAIT_V(n) asm volatile("s_waitcnt vmcnt(" #n ")" ::: "memory")
#define PG8_WAIT_L(n) asm volatile("s_waitcnt lgkmcnt(" #n ")" ::: "memory")
#define PG8_BAR __builtin_amdgcn_s_barrier()
#define PG8_SCHED __builtin_amdgcn_sched_barrier(0)
    Unit cur, nxt; int ui = 0;
    if (!S.next(0, cur)) return;
    unsigned gc[2][2], gn[2][2], g2[2][2];
#define PG8_GLOAD(g, u) do { _Pragma("unroll") for (int _i = 0; _i < 2; ++_i) { int R_, C_; stage_rc(tid * 16 + _i * 8192, R_, C_); _Pragma("unroll") for (int _h = 0; _h < 2; ++_h) \
        g[_h][_i] = (unsigned)gidx[(u).pm * 256 + _h * 128 + R_] * (unsigned)(K * 2) + (unsigned)(C_ * 2); } } while (0)
    if constexpr (GATHER) { PG8_GLOAD(gc, cur); }
    f32x4 acc[2][2][4][2];
#pragma unroll
    for (int a = 0; a < 2; ++a)
#pragma unroll
        for (int b = 0; b < 2; ++b)
#pragma unroll
            for (int m = 0; m < 4; ++m)
#pragma unroll
                for (int n = 0; n < 2; ++n) acc[a][b][m][n] = (f32x4){0.f, 0.f, 0.f, 0.f};
    bf16x8 At[4][2], B0[2][2], B1[2][2]; float pre[8];
    const char* cA = (const char*)Ag + (size_t)cur.pm * tstep; const char* cB = (const char*)Btg + (size_t)cur.pb * tstep;
    PG8_STAGE(PG8_SB(0, 0), cB, voffB); PG8_STAGE(PG8_SB(0, 1), cB + hstep, voffB);
    if constexpr (GATHER) { PG8_STAGE(PG8_SA(0, 0), Ag, gc[0]); PG8_STAGE(PG8_SA(0, 1), Ag, gc[1]); } else { PG8_STAGE(PG8_SA(0, 0), cA, voffA); PG8_STAGE(PG8_SA(0, 1), cA + hstep, voffA); }
    if (wr == 1) PG8_BAR;
    PG8_WAIT_V(2); PG8_BAR;
    PG8_STAGE(PG8_SB(1, 0), cB + kstep, voffB);
    if constexpr (GATHER) PG8_STAGE(PG8_SA(1, 0), (const char*)Ag + kstep, gc[0]); else PG8_STAGE(PG8_SA(1, 0), cA + kstep, voffA);
    PG8_STAGE(PG8_SB(1, 1), cB + hstep + kstep, voffB);
    PG8_WAIT_V(6); PG8_BAR;
    for (;;) {
        const bool has_next = S.next(ui + 1, nxt);
        const char* nA = has_next ? (const char*)Ag + (size_t)nxt.pm * tstep : cA; const char* nB = has_next ? (const char*)Btg + (size_t)nxt.pb * tstep : cB;
        if constexpr (GATHER) { if (has_next) { PG8_GLOAD(gn, nxt); } else { _Pragma("unroll") for (int _h = 0; _h < 2; ++_h) _Pragma("unroll") for (int _i = 0; _i < 2; ++_i) gn[_h][_i] = gc[_h][_i]; } }
#pragma unroll 1
        for (int t = 0; t < nt; t += 2) {
            if constexpr (Epi::HAS_MID) { if (t == (nt >> 1)) E.mid(acc, cur, wr, wc, fr, fq); }
            if constexpr (Epi::HAS_PRE) { if (t == nt - 4) E.pre_issue(pre, cur, wr, wc, fr, fq); if (t == nt - 2) E.pre_wait(pre); }
            const bool last = (t == nt - 2);
            const char* a1 = cA + (size_t)(t + 1) * kstep;
            const char* a2 = last ? nA : cA + (size_t)(t + 2) * kstep; const char* b2 = last ? nB : cB + (size_t)(t + 2) * kstep;
            const char* a3 = a2 + kstep; const char* b3 = b2 + kstep;
            const char* ka1 = (const char*)Ag + (size_t)(t + 1) * kstep; const char* ka2 = last ? (const char*)Ag : (const char*)Ag + (size_t)(t + 2) * kstep; const char* ka3 = ka2 + kstep;
            if constexpr (GATHER) { _Pragma("unroll") for (int _h = 0; _h < 2; ++_h) _Pragma("unroll") for (int _i = 0; _i < 2; ++_i) g2[_h][_i] = last ? gn[_h][_i] : gc[_h][_i]; }
#define PG8_STAGE_A(buf, h, apt, kapt, goff) do { if constexpr (GATHER) PG8_STAGE(PG8_SA(buf, h), kapt, goff[h]); else PG8_STAGE(PG8_SA(buf, h), (apt) + (h) * hstep, voffA); } while (0)
            PG8_LDB(B0, 0, 0); PG8_LDB(B1, 0, 1); PG8_SCHED; PG8_LDA(At, 0, 0); PG8_STAGE_A(1, 1, a1, ka1, gc);
            PG8_WAIT_V(8); PG8_WAIT_L(0); PG8_BAR; PG8_MMA(0, 0, At, B0); PG8_MMA(0, 1, At, B1); PG8_BAR; PG8_SCHED;
            PG8_LDA(At, 0, 1); PG8_STAGE(PG8_SB(0, 0), b2, voffB); PG8_STAGE(PG8_SB(0, 1), b2 + hstep, voffB); PG8_STAGE_A(0, 0, a2, ka2, g2);
            PG8_WAIT_V(8); PG8_WAIT_L(0); PG8_BAR; PG8_MMA(1, 0, At, B0); PG8_MMA(1, 1, At, B1); PG8_BAR; PG8_SCHED;
            PG8_LDB(B0, 1, 0); PG8_LDB(B1, 1, 1); PG8_SCHED; PG8_LDA(At, 1, 0); PG8_STAGE_A(0, 1, a2, ka2, g2);
            PG8_WAIT_V(8); PG8_WAIT_L(0); PG8_BAR; PG8_MMA(0, 0, At, B0); PG8_MMA(0, 1, At, B1); PG8_BAR; PG8_SCHED;
            PG8_LDA(At, 1, 1); PG8_STAGE(PG8_SB(1, 0), b3, voffB); PG8_STAGE(PG8_SB(1, 1), b3 + hstep, voffB); PG8_STAGE_A(1, 0, a3, ka3, g2);
            PG8_WAIT_V(8); PG8_WAIT_L(0); PG8_BAR; PG8_MMA(1, 0, At, B0); PG8_MMA(1, 1, At, B1); PG8_BAR; PG8_SCHED;
        }
        if constexpr (ALIGN_EPI) { if (wr == 0) PG8_BAR; }
        if constexpr (Epi::HAS_PRE) E.run(acc, cur, wr, wc, fr, fq, pre); else E(acc, cur, wr, wc, fr, fq);
        if (!has_next) break;
#pragma unroll
        for (int a = 0; a < 2; ++a)
#pragma unroll
            for (int b = 0; b < 2; ++b)
#pragma unroll
                for (int m = 0; m < 4; ++m)
#pragma unroll
                    for (int n = 0; n < 2; ++n) acc[a][b][m][n] = (f32x4){0.f, 0.f, 0.f, 0.f};
        cur = nxt; cA = nA; cB = nB; ++ui;
        if constexpr (GATHER) { _Pragma("unroll") for (int _h = 0; _h < 2; ++_h) _Pragma("unroll") for (int _i = 0; _i < 2; ++_i) gc[_h][_i] = gn[_h][_i]; }
        if constexpr (ALIGN_EPI) { if (wr == 1) PG8_BAR; }
    }
    PG8_WAIT_V(0);
    if constexpr (!ALIGN_EPI) { if (wr == 0) PG8_BAR; }
    PG8_BAR;
#undef PG8_SA
#undef PG8_SB
#undef PG8_STAGE
#undef PG8_LDA
#undef PG8_LDB
#undef PG8_MMA
#undef PG8_WAIT_V
#undef PG8_WAIT_L
#undef PG8_BAR
#undef PG8_SCHED
#undef PG8_GLOAD
#undef PG8_STAGE_A
}
}
using pg8::Unit;

constexpr size_t MiB = 1u << 20;
constexpr size_t WS_CTL = 0, CTL_ZERO_BYTES = 1 * MiB;
constexpr size_t WS_ZROW = 896 * 1024;
constexpr size_t WS_SSQ = 512 * 1024;
constexpr size_t WS_MOD = 1 * MiB;
constexpr size_t WS_ROPE = 1 * MiB + 256 * 1024;
constexpr size_t WS_GV = 1 * MiB + 512 * 1024;
constexpr size_t WS_IDX = 1 * MiB + 768 * 1024;
constexpr size_t WS_WIN = 2 * MiB;
constexpr size_t WS_WUQ = 10 * MiB;
constexpr size_t WS_WUKV = 10 * MiB + 512 * 1024;
constexpr size_t WS_WPROJ = 11 * MiB;
constexpr size_t WS_WOUT = 13 * MiB;
constexpr size_t WS_WGU = 16 * MiB;
constexpr size_t WS_WD = 80 * MiB;
constexpr size_t WS_A = 112 * MiB, WS_B = 240 * MiB, WS_C = 368 * MiB, WS_END = 512 * MiB;
constexpr size_t WS_GATES = WS_A;
constexpr size_t WS_XE = WS_A;
constexpr size_t WS_YE = WS_A;
constexpr size_t WS_U = WS_B;
constexpr size_t WS_QM = WS_B;
constexpr size_t WS_KMN = WS_B + 48 * MiB;
constexpr size_t WS_VM = WS_B + 82 * MiB;
constexpr size_t WS_MIXR = WS_C;
constexpr size_t WS_H = WS_B;
constexpr size_t WS_QC = WS_C;
constexpr size_t WS_KVX = WS_C + 16 * MiB;
constexpr size_t WS_NQ = WS_C + 33 * MiB;
constexpr size_t WS_NK = WS_C + 65 * MiB;
constexpr size_t WS_NV = WS_C + 99 * MiB;
constexpr size_t WS_AFF = WS_C + 133 * MiB;
constexpr size_t WS_INV = WS_C + 135 * MiB;
constexpr size_t WS_T = WS_B;
constexpr size_t WS_U2 = WS_C + 64 * MiB;
static_assert(WS_NV + (size_t)MC * 512 * 2 <= WS_AFF && WS_INV + (size_t)MX * 16 * 4 <= WS_END && WS_VM + (size_t)MC * 512 * 2 <= WS_C && WS_KMN + (size_t)MC * 512 * 2 <= WS_VM, "ws map");
static_assert(WS_U2 + (size_t)MX * 1024 * 2 <= WS_AFF && WS_QM + (size_t)MX * 768 * 2 <= WS_KMN && WS_KVX + (size_t)MC * 256 * 2 <= WS_NQ && WS_NQ + (size_t)MX * 512 * 2 <= WS_NK && WS_NK + (size_t)MC * 512 * 2 <= WS_NV, "ws map 2");
constexpr int CW_MODFLAG = 2048;
constexpr int CW_BAR = 4096;

constexpr int RING_OFF = 0, RING_BYTES = 131072;
constexpr int LDSCTL_OFF = RING_BYTES, MISC_OFF = LDSCTL_OFF + 320;
constexpr int LDS_BYTES = 147456;
constexpr int NWAVES = 8;

typedef GAS unsigned gu32;
#define RLX_AGENT __ATOMIC_RELAXED, __HIP_MEMORY_SCOPE_AGENT
#define LDS_WAIT() asm volatile("s_waitcnt lgkmcnt(0)" ::: "memory")
#define VM_WAIT() asm volatile("s_waitcnt vmcnt(0)" ::: "memory")

#define XB_TMO      128
#define XB_XCNT(j)  (256  + 64 * (j))
#define XB_XSUB(j)  (1280 + 64 * (j))
#define XB_XGEN(j)  (2304 + 64 * (j))
#define XB_TOP      3328
#define XB_TOPGEN   3392
#define XCD_BAR_WORDS 3456
#define XB_SPIN_CAP (1u << 20)
__device__ __forceinline__ unsigned xb_ld(unsigned* p)              { return __hip_atomic_load(p, __ATOMIC_RELAXED, __HIP_MEMORY_SCOPE_AGENT); }
__device__ __forceinline__ unsigned xb_add(unsigned* p, unsigned v) { return __hip_atomic_fetch_add(p, v, __ATOMIC_RELAXED, __HIP_MEMORY_SCOPE_AGENT); }
__device__ __forceinline__ unsigned xb_xcc_id() { return (unsigned)__builtin_amdgcn_s_getreg((3 << 11) | 20) & 0xFu; }
#define XB_SPIN(cond, bar) do { unsigned _sp = 0; while (cond) { __builtin_amdgcn_s_sleep(1); \
    if ((++_sp & 255u) == 0u) { if (xb_ld(&(bar)[XB_TMO])) break; if (_sp > XB_SPIN_CAP) { atomicAdd(&(bar)[XB_TMO], 1u); break; } } } } while (0)
struct XcdBarrier { unsigned* bar; unsigned x; volatile LAS unsigned* st; };
__device__ __forceinline__ XcdBarrier xcd_barrier_post(unsigned* bar, volatile LAS unsigned* st) {
    XcdBarrier b; b.bar = bar; b.x = xb_xcc_id(); b.st = st;
    if (threadIdx.x == 0) (void)xb_add(&bar[XB_XCNT(b.x)], 1u);
    return b;
}
__device__ __forceinline__ void xcd_barrier_complete(unsigned* bar, unsigned x, unsigned& nloc, unsigned& nx) {
    const unsigned G = gridDim.x * gridDim.y * gridDim.z;
    unsigned sum, cnt, mine, sp = 0u;
    for (;;) {
        sum = 0u; cnt = 0u; mine = 0u;
#pragma unroll
        for (unsigned j = 0; j < 16; ++j) { const unsigned c = xb_ld(&bar[XB_XCNT(j)]); sum += c; cnt += (c > 0u) ? 1u : 0u; mine = (j == x) ? c : mine; }
        if (sum == G) break;
        __builtin_amdgcn_s_sleep(1);
        if ((++sp & 255u) == 0u) { if (xb_ld(&bar[XB_TMO])) break; if (sp > XB_SPIN_CAP) { atomicAdd(&bar[XB_TMO], 1u); break; } }
    }
    nloc = mine > 0u ? mine : 1u; nx = cnt > 0u ? cnt : 1u;
}
__device__ __forceinline__ void xcd_barrier(const XcdBarrier& b) {
    asm volatile("s_waitcnt vmcnt(0)" ::: "memory");
    __syncthreads();
    if (threadIdx.x == 0) {
        unsigned* bar = b.bar;
        __builtin_amdgcn_s_waitcnt(0);
        unsigned nloc = b.st[0], nx = b.st[1];
        if (nloc == 0u) { xcd_barrier_complete(bar, b.x, nloc, nx); b.st[0] = nloc; b.st[1] = nx; }
        const unsigned old = xb_add(&bar[XB_XSUB(b.x)], 1u);
        const unsigned gen = old / nloc;
        if (old + 1u == (gen + 1u) * nloc) {
            __builtin_amdgcn_fence(__ATOMIC_RELEASE, "agent");
            asm volatile("s_waitcnt vmcnt(0)" ::: "memory");
            const unsigned og = xb_add(&bar[XB_TOP], 1u);
            const unsigned tg = og / nx;
            if (og + 1u == (tg + 1u) * nx) xb_add(&bar[XB_TOPGEN], 1u);
            else XB_SPIN(xb_ld(&bar[XB_TOPGEN]) == tg, bar);
            __builtin_amdgcn_fence(__ATOMIC_ACQUIRE, "agent");
            xb_add(&bar[XB_XGEN(b.x)], 1u);
            asm volatile("s_waitcnt vmcnt(0)" ::: "memory");
        } else {
            XB_SPIN(xb_ld(&bar[XB_XGEN(b.x)]) == gen, bar);
            __builtin_amdgcn_fence(__ATOMIC_ACQUIRE, "agent");
            asm volatile("s_waitcnt vmcnt(0)" ::: "memory");
        }
    }
    __syncthreads();
}

struct Frame {
    LAS unsigned char* lds;
    volatile LAS unsigned* MISC;
    int tid, lane, wave;
    int vcu, G;
    unsigned char* ws;
    const float* in[23];
    float* out;
};
template <int CTRL> __device__ __forceinline__ float dppf(float v) { return __int_as_float(__builtin_amdgcn_update_dpp(0, __float_as_int(v), CTRL, 0xf, 0xf, true)); }
__device__ __forceinline__ float rlane(float v, int l) { return __int_as_float(__builtin_amdgcn_readlane(__float_as_int(v), l)); }
#define DPP_XOR1 0xB1
#define DPP_XOR2 0x4E
#define DPP_QREV 0x1B
#define DPP_HMIR 0x141
#define DPP_RMIR 0x140
#define DPP_ROR8 0x128
__device__ __forceinline__ float lane_xor4(float v) { return dppf<DPP_HMIR>(dppf<DPP_QREV>(v)); }
__device__ __forceinline__ float wave_sum_q(float v) {
    v += dppf<DPP_HMIR>(v); v += dppf<DPP_RMIR>(v);
    { const auto q = __builtin_amdgcn_permlane16_swap(__float_as_uint(v), __float_as_uint(v), false, false); v = __uint_as_float(q[0]) + __uint_as_float(q[1]); }
    { const auto q = __builtin_amdgcn_permlane32_swap(__float_as_uint(v), __float_as_uint(v), false, false); v = __uint_as_float(q[0]) + __uint_as_float(q[1]); }
    return v;
}
__device__ __forceinline__ float wave_max_q(float v) {
    v = fmaxf(v, dppf<DPP_HMIR>(v)); v = fmaxf(v, dppf<DPP_RMIR>(v));
    { const auto q = __builtin_amdgcn_permlane16_swap(__float_as_uint(v), __float_as_uint(v), false, false); v = fmaxf(__uint_as_float(q[0]), __uint_as_float(q[1])); }
    { const auto q = __builtin_amdgcn_permlane32_swap(__float_as_uint(v), __float_as_uint(v), false, false); v = fmaxf(__uint_as_float(q[0]), __uint_as_float(q[1])); }
    return v;
}
__device__ __forceinline__ float wave_sum(float v) { v += dppf<DPP_XOR1>(v); v += dppf<DPP_XOR2>(v); return wave_sum_q(v); }

struct SchedInProj {
    int G, c;
    __device__ __forceinline__ bool next(int i, Unit& u) const {
        const int L = i * G + c;
        constexpr int nM = 128, nN = 16, nwg = nM * nN;
        if (L < nwg) {
            int wgid = L; { const int q = nwg / 8, xcd = wgid % 8, off = wgid / 8; wgid = xcd * q + off; }
            const int nig = 8 * nN, gid = wgid / nig, fm = gid * 8;
            const int xpm = fm + ((wgid % nig) % 8); u.pn = (wgid % nig) / 8;
            u.pm = (xpm >> 4) * 17 + 1 + (xpm & 15); u.pb = u.pn; return true;
        }
        const int Lc = L - nwg; if (Lc >= 40) return false;
        u.pm = (Lc / 5) * 17; u.pn = Lc % 5; u.pb = u.pn; return true;
    }
};
struct SchedDense {
    int nM, nN, G, c;
    __device__ __forceinline__ bool next(int i, Unit& u) const {
        const int nwg = nM * nN; const long L = (long)i * G + c; if (L >= nwg) return false;
        int wgid = (int)L; { const int q = nwg / 8, r = nwg % 8, xcd = wgid % 8, off = wgid / 8; wgid = (xcd < r ? xcd * (q + 1) : r * (q + 1) + (xcd - r) * q) + off; }
        const int nig = 8 * nN, gid = wgid / nig, fm = gid * 8, gsz = (nM - fm) < 8 ? (nM - fm) : 8;
        u.pm = fm + ((wgid % nig) % gsz); u.pn = (wgid % nig) / gsz; u.pb = u.pn; return true;
    }
};
template <int NT> struct SchedExpert {
    int vcu;
    __device__ __forceinline__ bool next(int i, Unit& u) const {
        constexpr int RPE = NT / 4 * 2;
        if (i >= 2 * RPE) return false;
        const int xcd = vcu >> 5, w = vcu & 31, e = 2 * xcd + i / RPE, s = i % RPE;
        const int rt = 8 * (s / (NT / 4)) + (w & 7), ct = 4 * (s % (NT / 4)) + (w >> 3);
        u.pm = e * 16 + rt; u.pn = ct; u.pb = e * NT + ct; return true;
    }
};

__device__ __forceinline__ int opaque(int v) { asm volatile("" : "+v"(v)); return v; }
__device__ __forceinline__ u32x4 pack8(const f32x4 a, const f32x4 b) { u32x4 w; w.x = cvtpk(a[0], a[1]); w.y = cvtpk(a[2], a[3]); w.z = cvtpk(b[0], b[1]); w.w = cvtpk(b[2], b[3]); return w; }
__device__ __forceinline__ float sigmoidf_(float v) { return __builtin_amdgcn_rcpf(1.f + __builtin_amdgcn_exp2f(-v * LOG2E)); }
__device__ __forceinline__ float rows_sum(float v) {
    { const auto q = __builtin_amdgcn_permlane16_swap(__float_as_uint(v), __float_as_uint(v), false, false); v = __uint_as_float(q[0]) + __uint_as_float(q[1]); }
    { const auto q = __builtin_amdgcn_permlane32_swap(__float_as_uint(v), __float_as_uint(v), false, false); v = __uint_as_float(q[0]) + __uint_as_float(q[1]); }
    return v;
}
__device__ __forceinline__ float sumsq8(const f32x4 a, const f32x4 b) { return (a[0] * a[0] + a[1] * a[1]) + (a[2] * a[2] + a[3] * a[3]) + (b[0] * b[0] + b[1] * b[1]) + (b[2] * b[2] + b[3] * b[3]); }
__device__ __forceinline__ void rope8(f32x4& a, f32x4& b, const f32x4 cs, const f32x4 sn) {
    const f32x4 a0 = a, b0 = b;
    a[0] = a0[0] * cs[0] - a0[1] * sn[0]; a[1] = a0[0] * sn[0] + a0[1] * cs[0];
    a[2] = a0[2] * cs[1] - a0[3] * sn[1]; a[3] = a0[2] * sn[1] + a0[3] * cs[1];
    b[0] = b0[0] * cs[2] - b0[1] * sn[2]; b[1] = b0[0] * sn[2] + b0[1] * cs[2];
    b[2] = b0[2] * cs[3] - b0[3] * sn[3]; b[3] = b0[2] * sn[3] + b0[3] * cs[3];
}

struct EpiInProj {
    static constexpr bool PERM = true, HAS_MID = false, HAS_PRE = false;
    bf16_t *KVX, *NK, *NV, *QC, *NQ, *GATES; float *ssq_kv, *ssq_q; const float* rope; float ssc;
    __device__ __forceinline__ void operator()(const f32x4 (&acc)[2][2][4][2], const Unit& u, int wr, int wc, int fr_, int fq) const {
        const int fr = opaque(fr_);
        const int b = u.pm / 17, jt = u.pm % 17, pn = u.pn;
        const int col8 = wc * 32 + 8 * fq;
#pragma unroll
        for (int ai = 0; ai < 2; ++ai)
#pragma unroll
            for (int m = 0; m < 4; ++m) {
                const int rl = ai * 128 + wr * 64 + m * 16 + fr;
                const size_t mrow = (size_t)u.pm * 256 + rl;
                const size_t xrow = (size_t)(b * 16 + jt - 1) * 256 + rl;
                if (pn == 0) {
                    f32x4 v0 = acc[ai][0][m][0], v1 = acc[ai][0][m][1];
                    *(u32x4*)(KVX + mrow * 256 + col8) = pack8(v0, v1);
                    float ss = rows_sum(sumsq8(v0, v1));
                    if (fq == 0) atomicAdd(ssq_kv + mrow, ss * ssc);
                    f32x4 w0 = acc[ai][1][m][0], w1 = acc[ai][1][m][1];
                    if (wc == 0) {
                        if (jt > 0) { const int t = (jt - 1) * 256 + rl, p = (fq < 2) ? (t >> 6) : (t & 63), f0 = (fq & 1) * 4;
                            const f32x4 cs = *(const f32x4*)(rope + p * 8 + f0), sn = *(const f32x4*)(rope + 512 + p * 8 + f0); rope8(w0, w1, cs, sn); }
                    } else { w0 = (f32x4){0.f, 0.f, 0.f, 0.f}; w1 = w0; }
                    *(u32x4*)(KVX + mrow * 256 + 128 + col8) = pack8(w0, w1);
                } else if (pn <= 4) {
                    bf16_t* dst = (pn <= 2 ? NK : NV) + mrow * 512 + ((pn - 1) & 1) * 256 + col8;
#pragma unroll
                    for (int bj = 0; bj < 2; ++bj) *(u32x4*)(dst + bj * 128) = pack8(acc[ai][bj][m][0], acc[ai][bj][m][1]);
                } else if (pn == 5) {
                    float ss = 0.f;
#pragma unroll
                    for (int bj = 0; bj < 2; ++bj) { *(u32x4*)(QC + xrow * 256 + bj * 128 + col8) = pack8(acc[ai][bj][m][0], acc[ai][bj][m][1]); ss += sumsq8(acc[ai][bj][m][0], acc[ai][bj][m][1]); }
                    ss = rows_sum(ss);
                    if (fq == 0) atomicAdd(ssq_q + xrow, ss * ssc);
                } else if (pn <= 7) {
#pragma unroll
                    for (int bj = 0; bj < 2; ++bj) *(u32x4*)(NQ + xrow * 512 + (pn - 6) * 256 + bj * 128 + col8) = pack8(acc[ai][bj][m][0] * NA_QS, acc[ai][bj][m][1] * NA_QS);
                } else {
                    f32x4 a0 = acc[ai][0][m][0], a1 = acc[ai][0][m][1], n0 = acc[ai][1][m][0], n1 = acc[ai][1][m][1];
#pragma unroll
                    for (int k = 0; k < 4; ++k) {
                        const float dn0 = 1.f + __builtin_amdgcn_exp2f(n0[k]), dn1 = 1.f + __builtin_amdgcn_exp2f(n1[k]);
                        const float dm0 = 1.f + __builtin_amdgcn_exp2f(a0[k]), dm1 = 1.f + __builtin_amdgcn_exp2f(a1[k]);
                        n0[k] = __builtin_amdgcn_rcpf(dn0); n1[k] = __builtin_amdgcn_rcpf(dn1); a0[k] = dn0 * __builtin_amdgcn_rcpf(dm0); a1[k] = dn1 * __builtin_amdgcn_rcpf(dm1); }
                    *(u32x4*)(GATES + xrow * 2048 + (pn - 8) * 128 + col8) = pack8(a0, a1);
                    *(u32x4*)(GATES + xrow * 2048 + 1024 + (pn - 8) * 128 + col8) = pack8(n0, n1);
                }
            }
    }
};
struct EpiQUp {
    static constexpr bool PERM = true, HAS_MID = false, HAS_PRE = false;
    bf16_t* QM; const float* ssq_q; const float* rope;
    __device__ __forceinline__ void operator()(const f32x4 (&acc)[2][2][4][2], const Unit& u, int wr, int wc, int fr_, int fq) const {
        const int fr = opaque(fr_);
        float rs8[8];
#pragma unroll
        for (int i = 0; i < 8; ++i) rs8[i] = ssq_q[(size_t)u.pm * 256 + (i >> 2) * 128 + wr * 64 + (i & 3) * 16 + fr];
        int f0[2]; bool isr[2], hi8[2];
#pragma unroll
        for (int bj = 0; bj < 2; ++bj) { const int c0 = u.pn * 256 + bj * 128 + wc * 32 + 8 * fq, d0 = c0 % 96; isr[bj] = d0 >= 64; const int i0 = (isr[bj] ? d0 - 64 : 0) >> 1; hi8[bj] = i0 >= 8; f0[bj] = i0 & 7; }
        f32x4 csn[2], snn[2];
#define QUP_ISSUE(it) do { const int t_ = (int)(((size_t)u.pm * 256 + ((it) >> 2) * 128 + wr * 64 + ((it) & 3) * 16 + fr) & 4095); \
            _Pragma("unroll") for (int bj = 0; bj < 2; ++bj) { const int p_ = hi8[bj] ? (t_ & 63) : (t_ >> 6); \
                csn[bj] = *(const f32x4*)(rope + p_ * 8 + f0[bj]); snn[bj] = *(const f32x4*)(rope + 512 + p_ * 8 + f0[bj]); } } while (0)
        QUP_ISSUE(0);
        asm volatile("" ::: "memory");
#pragma unroll
        for (int it = 0; it < 8; ++it) {
            const int ai = it >> 2, m = it & 3;
            asm volatile("" : "+v"(csn[0]), "+v"(csn[1]), "+v"(snn[0]), "+v"(snn[1]));
            const f32x4 cs0 = csn[0], cs1 = csn[1], sn0 = snn[0], sn1 = snn[1];
            if (it < 7) QUP_ISSUE(it + 1);
            const size_t xrow = (size_t)u.pm * 256 + ai * 128 + wr * 64 + m * 16 + fr;
            const float rs = MLA_QS * __builtin_amdgcn_rsqf(rs8[it] * (1.f / 256.f) + RMS_EPS);
#pragma unroll
            for (int bj = 0; bj < 2; ++bj) { const int c0 = u.pn * 256 + bj * 128 + wc * 32 + 8 * fq;
                f32x4 v0 = acc[ai][bj][m][0], v1 = acc[ai][bj][m][1];
                if (isr[bj]) rope8(v0, v1, bj ? cs1 : cs0, bj ? sn1 : sn0);
                *(u32x4*)(QM + xrow * 768 + c0) = pack8(v0 * rs, v1 * rs); }
            asm volatile("" ::: "memory");
        }
#undef QUP_ISSUE
    }
};
struct EpiKVUp {
    static constexpr bool PERM = true, HAS_MID = false, HAS_PRE = false;
    bf16_t *KMN, *VM; const float* ssq_kv;
    __device__ __forceinline__ void operator()(const f32x4 (&acc)[2][2][4][2], const Unit& u, int wr, int wc, int fr_, int fq) const {
        const int fr = opaque(fr_);
        bf16_t* base = (u.pn < 2 ? KMN : VM) + (u.pn & 1) * 256 + wc * 32 + 8 * fq;
        float rs8[8];
#pragma unroll
        for (int i = 0; i < 8; ++i) rs8[i] = ssq_kv[(size_t)u.pm * 256 + (i >> 2) * 128 + wr * 64 + (i & 3) * 16 + fr];
        asm volatile("" : "+v"(rs8[0]), "+v"(rs8[1]), "+v"(rs8[2]), "+v"(rs8[3]), "+v"(rs8[4]), "+v"(rs8[5]), "+v"(rs8[6]), "+v"(rs8[7]) :: "memory");
#pragma unroll
        for (int ai = 0; ai < 2; ++ai)
#pragma unroll
            for (int m = 0; m < 4; ++m) {
                const size_t mrow = (size_t)u.pm * 256 + ai * 128 + wr * 64 + m * 16 + fr;
                const float rs = __builtin_amdgcn_rsqf(rs8[ai * 4 + m] * (1.f / 128.f) + RMS_EPS);
#pragma unroll
                for (int bj = 0; bj < 2; ++bj) *(u32x4*)(base + mrow * 512 + bj * 128) = pack8(acc[ai][bj][m][0] * rs, acc[ai][bj][m][1] * rs);
            }
    }
};
static_assert(WS_KVX - WS_QC == (size_t)128 * 256 * 256 * 2 && WS_WUKV - WS_WUQ == (size_t)4 * 256 * 256 * 2, "tile-index aliasing of the up-projection operands");
struct SchedUp {
    int G, c;
    __device__ __forceinline__ bool next(int i, Unit& u) const {
        const int L = i * G + c; if (L >= 928) return false;
        if (L < 544) { u.pn = L & 3; u.pm = 128 + (L >> 2); u.pb = 4 + u.pn; }
        else { const int q = L - 544; u.pn = q % 3; u.pm = q / 3; u.pb = u.pn; }
        return true;
    }
};
struct EpiUp {
    static constexpr bool PERM = true, HAS_MID = false, HAS_PRE = false;
    EpiQUp Q; EpiKVUp KV;
    __device__ __forceinline__ void operator()(const f32x4 (&acc)[2][2][4][2], const Unit& u, int wr, int wc, int fr, int fq) const {
        if (u.pb >= 4) { Unit v = u; v.pm = u.pm - 128; KV(acc, v, wr, wc, fr, fq); } else Q(acc, u, wr, wc, fr, fq);
    }
};
struct EpiMerge {
    static constexpr bool PERM = true, HAS_MID = true, HAS_PRE = false;
    bf16_t* T; const bf16_t* GATES;
    __device__ __forceinline__ void mid(f32x4 (&acc)[2][2][4][2], const Unit& u, int wr, int wc, int fr_, int fq) const {
        const int fr = opaque(fr_);
        const bf16_t* gb = GATES + ((size_t)u.pm * 256 + wr * 64 + fr) * 2048 + u.pn * 256 + wc * 32 + 8 * fq;
        u32x4 R[2][4][2];
#pragma unroll
        for (int ai = 0; ai < 2; ++ai)
#pragma unroll
            for (int m = 0; m < 4; ++m)
#pragma unroll
                for (int bj = 0; bj < 2; ++bj) R[ai][m][bj] = *(const u32x4*)(gb + (size_t)(ai * 128 + m * 16) * 2048 + bj * 128);
        asm volatile("" ::: "memory");
#pragma unroll
        for (int ai = 0; ai < 2; ++ai)
#pragma unroll
            for (int m = 0; m < 4; ++m)
#pragma unroll
                for (int bj = 0; bj < 2; ++bj)
#pragma unroll
                    for (int k = 0; k < 4; ++k) { acc[ai][bj][m][k >> 1][(k & 1) * 2] *= bflo(R[ai][m][bj][k]); acc[ai][bj][m][k >> 1][(k & 1) * 2 + 1] *= bfhi(R[ai][m][bj][k]); }
    }
    __device__ __forceinline__ void operator()(const f32x4 (&acc)[2][2][4][2], const Unit& u, int wr, int wc, int fr_, int fq) const {
        const int fr = opaque(fr_);
        const bf16_t* gb = GATES + ((size_t)u.pm * 256 + wr * 64 + fr) * 2048 + 1024 + u.pn * 256 + wc * 32 + 8 * fq;
        u32x4 R[2][4][2];
#pragma unroll
        for (int ai = 0; ai < 2; ++ai)
#pragma unroll
            for (int m = 0; m < 4; ++m)
#pragma unroll
                for (int bj = 0; bj < 2; ++bj) R[ai][m][bj] = *(const u32x4*)(gb + (size_t)(ai * 128 + m * 16) * 2048 + bj * 128);
        asm volatile("" ::: "memory");
#pragma unroll
        for (int ai = 0; ai < 2; ++ai)
#pragma unroll
            for (int m = 0; m < 4; ++m) {
                const size_t xrow = (size_t)u.pm * 256 + ai * 128 + wr * 64 + m * 16 + fr;
#pragma unroll
                for (int bj = 0; bj < 2; ++bj) { const int c0 = u.pn * 256 + bj * 128 + wc * 32 + 8 * fq;
                    const u32x4 g2 = R[ai][m][bj];
                    f32x4 v0 = acc[ai][bj][m][0], v1 = acc[ai][bj][m][1];
                    v0[0] *= bflo(g2[0]); v0[1] *= bfhi(g2[0]); v0[2] *= bflo(g2[1]); v0[3] *= bfhi(g2[1]);
                    v1[0] *= bflo(g2[2]); v1[1] *= bfhi(g2[2]); v1[2] *= bflo(g2[3]); v1[3] *= bfhi(g2[3]);
                    *(u32x4*)(T + xrow * 1024 + c0) = pack8(v0, v1); }
            }
    }
};
struct EpiOut {
    static constexpr bool PERM = true, HAS_MID = false, HAS_PRE = false;
    bf16_t* MIXR;
    __device__ __forceinline__ void operator()(const f32x4 (&acc)[2][2][4][2], const Unit& u, int wr, int wc, int fr_, int fq) const {
        const int fr = opaque(fr_);
#pragma unroll
        for (int ai = 0; ai < 2; ++ai)
#pragma unroll
            for (int m = 0; m < 4; ++m) { const size_t row = (size_t)u.pm * 256 + ai * 128 + wr * 64 + m * 16 + fr;
#pragma unroll
                for (int bj = 0; bj < 2; ++bj) *(u32x4*)(MIXR + row * 1024 + u.pn * 256 + bj * 128 + wc * 32 + 8 * fq) = pack8(acc[ai][bj][m][0], acc[ai][bj][m][1]); }
    }
};
struct EpiSwiGLU {
    static constexpr bool PERM = true, HAS_MID = false, HAS_PRE = false;
    bf16_t* H;
    __device__ __forceinline__ void operator()(const f32x4 (&acc)[2][2][4][2], const Unit& u, int wr, int wc, int fr_, int fq) const {
        const int fr = opaque(fr_);
#pragma unroll
        for (int ai = 0; ai < 2; ++ai)
#pragma unroll
            for (int m = 0; m < 4; ++m) { const size_t row = (size_t)u.pm * 256 + ai * 128 + wr * 64 + m * 16 + fr;
                f32x4 h0, h1;
#pragma unroll
                for (int k = 0; k < 4; ++k) { const float g0 = acc[ai][0][m][0][k], g1 = acc[ai][0][m][1][k];
                    h0[k] = g0 * __builtin_amdgcn_rcpf(1.f + __builtin_amdgcn_exp2f(-g0)) * acc[ai][1][m][0][k]; h1[k] = g1 * __builtin_amdgcn_rcpf(1.f + __builtin_amdgcn_exp2f(-g1)) * acc[ai][1][m][1][k]; }
                *(u32x4*)(H + row * 1024 + u.pn * 128 + wc * 32 + 8 * fq) = pack8(h0, h1); }
    }
};
struct EpiDown {
    static constexpr bool PERM = true, HAS_MID = false, HAS_PRE = true;
    bf16_t* YE; const float* GV;
    __device__ __forceinline__ void pre_issue(float (&pre)[8], const Unit& u, int wr, int wc, int fr_, int fq) const {
        const unsigned off0 = (unsigned)(u.pm * 256 + wr * 64 + opaque(fr_)) * 4u;
#pragma unroll
        for (int i = 0; i < 8; ++i) { const unsigned off = off0 + (unsigned)((i >> 2) * 128 + (i & 3) * 16) * 4u;
            asm volatile("global_load_dword %0, %1, %2" : "=v"(pre[i]) : "v"(off), "s"(GV) : "memory"); }
    }
    __device__ __forceinline__ void pre_wait(float (&pre)[8]) const {
        asm volatile("s_waitcnt vmcnt(16)" : "+v"(pre[0]), "+v"(pre[1]), "+v"(pre[2]), "+v"(pre[3]), "+v"(pre[4]), "+v"(pre[5]), "+v"(pre[6]), "+v"(pre[7]) :: "memory");
    }
    __device__ __forceinline__ void run(const f32x4 (&acc)[2][2][4][2], const Unit& u, int wr, int wc, int fr_, int fq, const float (&pre)[8]) const {
        const int fr = opaque(fr_);
#pragma unroll
        for (int ai = 0; ai < 2; ++ai)
#pragma unroll
            for (int m = 0; m < 4; ++m) { const size_t row = (size_t)u.pm * 256 + ai * 128 + wr * 64 + m * 16 + fr; const float g = pre[ai * 4 + m];
#pragma unroll
                for (int bj = 0; bj < 2; ++bj) *(u32x4*)(YE + row * 1024 + u.pn * 256 + bj * 128 + wc * 32 + 8 * fq) = pack8(acc[ai][bj][m][0] * g, acc[ai][bj][m][1] * g); }
    }
    __device__ __forceinline__ void operator()(const f32x4 (&acc)[2][2][4][2], const Unit& u, int wr, int wc, int fr, int fq) const {}
};

namespace att {
constexpr int KVBLK = 64, QBLK = 32;
constexpr int SHM_V = 64 * 64 * 2, SHM_K = 64 * 256;
constexpr int L_V = 0, L_K = 2 * SHM_V, L_WS = L_K + 2 * SHM_K, L_OST = L_WS + NWAVES * 64 * 4, L_BL = L_OST + NWAVES * 4096, L_END = L_BL + 2048;
static_assert(L_END <= RING_BYTES, "attention LDS");
constexpr float THR = 8.f;
#define KSWZ(row, colB) ((row) * 256 + ((colB) ^ (((row) & 7) << 4)))
#define SBAR() __builtin_amdgcn_sched_barrier(0)
__device__ __forceinline__ int crow(int r, int hi) { return (r & 3) + 8 * (r >> 2) + 4 * hi; }
template <bool FIRST>
__device__ __forceinline__ void partialSM(f32x16& p0, f32x16& p1, float& m_reg, f32x16& negm, float& alpha) {
  float pmax = p0[0];
#pragma unroll
  for (int r = 1; r < 16; ++r) pmax = fmaxf(pmax, p0[r]);
#pragma unroll
  for (int r = 0; r < 16; ++r) pmax = fmaxf(pmax, p1[r]);
  { auto rr = __builtin_amdgcn_permlane32_swap(__float_as_uint(pmax), __float_as_uint(pmax), false, false);
    pmax = fmaxf(__uint_as_float(rr[0]), __uint_as_float(rr[1])); }
  if (!FIRST && __builtin_expect(__all(pmax <= THR), 1)) { alpha = 1.f; }
  else { const float d = FIRST ? pmax : fmaxf(pmax, 0.f); m_reg += d; alpha = __builtin_amdgcn_exp2f(-d);
#pragma unroll
    for (int r = 0; r < 16; ++r) { p0[r] -= d; p1[r] -= d; }
#pragma unroll
    for (int r = 0; r < 16; ++r) negm[r] = -m_reg;
    asm volatile("" : "+v"(negm)); }
#pragma unroll
  for (int r = 0; r < 16; ++r) p0[r] = __builtin_amdgcn_exp2f(p0[r]);
}
__device__ __forceinline__ void finishSM(f32x16& p0, f32x16& p1, float alpha, float& l_reg, bf16x8& pa0, bf16x8& pa1, bf16x8& pa2, bf16x8& pa3) {
#pragma unroll
  for (int r = 0; r < 16; ++r) p1[r] = __builtin_amdgcn_exp2f(p1[r]);
  float ps = 0;
#pragma unroll
  for (int r = 0; r < 16; ++r) ps += p0[r];
#pragma unroll
  for (int r = 0; r < 16; ++r) ps += p1[r];
  { auto rr = __builtin_amdgcn_permlane32_swap(__float_as_uint(ps), __float_as_uint(ps), false, false);
    ps = __uint_as_float(rr[0]) + __uint_as_float(rr[1]); }
  l_reg = l_reg * alpha + ps;
#define PK4(P, BASE, OUT) do { unsigned a0 = cvtpk(P[BASE + 0], P[BASE + 1]), a1 = cvtpk(P[BASE + 2], P[BASE + 3]);   \
    unsigned b0 = cvtpk(P[BASE + 4], P[BASE + 5]), b1 = cvtpk(P[BASE + 6], P[BASE + 7]);                              \
    auto r0 = __builtin_amdgcn_permlane32_swap(a0, b0, false, false); auto r1 = __builtin_amdgcn_permlane32_swap(a1, b1, false, false); \
    u32x4 w = {r0[0], r1[0], r0[1], r1[1]}; OUT = __builtin_bit_cast(bf16x8, w); } while (0)
  PK4(p0, 0, pa0); PK4(p0, 8, pa1); PK4(p1, 0, pa2); PK4(p1, 8, pa3);
#undef PK4
}
template <int NKS> __device__ __forceinline__ void qkt(f32x16& p0, f32x16& p1, const char* Ks, const bf16x8* qr, const f32x16& negm, int r32, int hi) {
  p0 = negm; p1 = negm;
#pragma unroll
  for (int d0 = 0; d0 < NKS; ++d0) { const int cb = (d0 * 16 + hi * 8) * 2;
    const bf16x8 b0 = *reinterpret_cast<const bf16x8*>(Ks + KSWZ(r32, cb));
    const bf16x8 b1 = *reinterpret_cast<const bf16x8*>(Ks + KSWZ(32 + r32, cb));
    p0 = __builtin_amdgcn_mfma_f32_32x32x16_bf16(b0, qr[d0], p0, 0, 0, 0);
    p1 = __builtin_amdgcn_mfma_f32_32x32x16_bf16(b1, qr[d0], p1, 0, 0, 0); }
}
__device__ __forceinline__ int v_st(int k, int c) { const int kk = (k & ~0xC) | ((k & 4) << 1) | ((k & 8) >> 1); return ((kk >> 3) * 2 + (c >> 5)) * 512 + ((kk & 7) * 32 + (c & 31)) * 2; }
__device__ __forceinline__ int v_rd_base(int lane) { return ((lane & 3) << 3) | (((lane >> 2) & 3) << 6) | (((lane >> 4) & 1) << 5) | (((lane >> 5) & 1) << 8); }
constexpr int v_rd_off(int d0, int ks, int half) { return d0 * 512 + ks * 2048 + half * 1024; }
template <int OFF> __device__ __forceinline__ s16x4 tr_read(int vb) {
  s16x4 r; asm volatile("ds_read_b64_tr_b16 %0, %1 offset:%2" : "=&v"(r) : "v"(vb), "i"(OFF) : "memory"); return r;
}
template <int D0> __device__ __forceinline__ void pv_one(f32x16& od, int vb, bf16x8 pa0, bf16x8 pa1, bf16x8 pa2, bf16x8 pa3) {
  const s16x4 l0 = tr_read<v_rd_off(D0, 0, 0)>(vb), h0 = tr_read<v_rd_off(D0, 0, 1)>(vb), l1 = tr_read<v_rd_off(D0, 1, 0)>(vb), h1 = tr_read<v_rd_off(D0, 1, 1)>(vb);
  const s16x4 l2 = tr_read<v_rd_off(D0, 2, 0)>(vb), h2 = tr_read<v_rd_off(D0, 2, 1)>(vb), l3 = tr_read<v_rd_off(D0, 3, 0)>(vb), h3 = tr_read<v_rd_off(D0, 3, 1)>(vb);
  asm volatile("s_waitcnt lgkmcnt(0)" ::: "memory"); SBAR();
#define PK(L, H) (bf16x8){L[0], L[1], L[2], L[3], H[0], H[1], H[2], H[3]}
  od = __builtin_amdgcn_mfma_f32_32x32x16_bf16(pa0, PK(l0, h0), od, 0, 0, 0);
  od = __builtin_amdgcn_mfma_f32_32x32x16_bf16(pa1, PK(l1, h1), od, 0, 0, 0);
  od = __builtin_amdgcn_mfma_f32_32x32x16_bf16(pa2, PK(l2, h2), od, 0, 0, 0);
  od = __builtin_amdgcn_mfma_f32_32x32x16_bf16(pa3, PK(l3, h3), od, 0, 0, 0);
#undef PK
}
__device__ __forceinline__ void pv_all(f32x16* o, int vb, bf16x8 pa0, bf16x8 pa1, bf16x8 pa2, bf16x8 pa3) {
  pv_one<0>(o[0], vb, pa0, pa1, pa2, pa3); pv_one<1>(o[1], vb, pa0, pa1, pa2, pa3);
}
struct Tensors { const bf16_t *QM, *KMN, *KVX, *VM, *NQ, *NK, *NV; bf16_t* Y; const float* rel_bias; };

template <bool NA>
__device__ __forceinline__ void attn_unit(const Tensors& T, int b, int h, int qb, char* lds) {
  constexpr int NKS = NA ? 4 : 6;
  const int tid = threadIdx.x, wid = __builtin_amdgcn_readfirstlane(tid >> 6), lane = tid & 63, r32 = lane & 31, hi = lane >> 5;
  char* V_lds = lds + L_V; char* K_lds = lds + L_K;
  float* ws = (float*)(lds + L_WS) + wid * 64; float* li_l = ws; float* al_l = ws + 32;
  float* BL = (float*)(lds + L_BL);
  float m_reg = 0.f, l_reg = 0; f32x16 o[2] = {}; bf16x8 qr[NKS]; f32x16 negm = {}; asm volatile("" : "+v"(negm));
  const size_t xrow0 = (size_t)b * SEQ + qb * 256 + wid * QBLK;
  {
    const bf16_t* Qw = NA ? T.NQ + (xrow0 + r32) * 512 + h * 64 + hi * 8 : T.QM + (xrow0 + r32) * 768 + h * 96 + hi * 8;
#pragma unroll
    for (int d0 = 0; d0 < NKS; ++d0) qr[d0] = *reinterpret_cast<const bf16x8*>(Qw + d0 * 16);
  }
  const size_t kbase = (size_t)b * SCOMB;
  int RLO = 0, nloc = 0, NT;
  if (NA) { RLO = min(max(4 * qb - 4, 0), 56); const int RHI = min(max(4 * qb - 1, 0), 56) + 7; nloc = RHI - RLO + 1; NT = 4 + nloc; }
  else NT = SCOMB / KVBLK;
  auto krow = [&](int t) -> size_t { if (!NA) return kbase + (size_t)t * 64; if (t < 4) return kbase + (size_t)t * 64; const int rr = min(RLO + t - 4, 63); return kbase + 256 + (size_t)rr * 64; };
  const int rw = 4 * qb + (wid >> 1), r0w = min(max(rw - 4, 0), 56);
  const int qc = (wid & 1) * 32 + r32, c0w = min(max(qc - 8, 0), 48);
  if (NA) { if (tid < 480) { const int dr = tid >> 5, i = tid & 31; BL[tid] = (i < 31) ? T.rel_bias[(h * 15 + dr) * 31 + i] * LOG2E : 0.f; } }
  const int sr = tid >> 3, sc8 = tid & 7;
  const int vst = v_st(sr, sc8 * 8), kst = KSWZ(sr, sc8 * 16), krst = KSWZ(tid >> 2, 128 + (tid & 3) * 16);
  const int vb0 = (int)(uintptr_t)V_lds + v_rd_base(lane);
  const bf16_t* Kg = NA ? T.NK + h * 64 + sc8 * 8 : T.KMN + h * 64 + sc8 * 8;
  const bf16_t* Vg = NA ? T.NV + h * 64 + sc8 * 8 : T.VM + h * 64 + sc8 * 8;
  const bf16_t* Rg = T.KVX + 128 + (tid & 3) * 8;
  struct { bf16x8 k, v, kr; } sr_[2];
#define SLOAD(i, t) do { const size_t row_ = krow(t); sr_[i].k = *reinterpret_cast<const bf16x8*>(Kg + (row_ + sr) * 512); sr_[i].v = *reinterpret_cast<const bf16x8*>(Vg + (row_ + sr) * 512); \
    if (!NA) { if (tid < 256) sr_[i].kr = *reinterpret_cast<const bf16x8*>(Rg + (row_ + (tid >> 2)) * 256); } } while (0)
#define SWRITE(bf, i) do { *(bf16x8*)(V_lds + (bf) * SHM_V + vst) = sr_[i].v; *(bf16x8*)(K_lds + (bf) * SHM_K + kst) = sr_[i].k; \
    if (!NA) { if (tid < 256) *(bf16x8*)(K_lds + (bf) * SHM_K + krst) = sr_[i].kr; } } while (0)
#define RESC(a) do { if (__any((a) < 1.f)) { if (hi == 0) al_l[r32] = (a); asm volatile("s_waitcnt lgkmcnt(0)" ::: "memory"); \
    _Pragma("unroll") for (int d = 0; d < 2; ++d) _Pragma("unroll") for (int r = 0; r < 16; ++r) o[d][r] *= al_l[crow(r, hi)]; } } while (0)
#define NAMASK(P0, P1, t) do { if (NA) { if ((t) >= 4) { const int rr_ = RLO + (t) - 4; const bool act_ = ((t) < 4 + nloc) && rr_ >= r0w && rr_ <= r0w + 7; \
    if (!act_) { _Pragma("unroll") for (int r = 0; r < 16; ++r) { P0[r] = -INFINITY; P1[r] = -INFINITY; } } \
    else { const float* bl_ = BL + (rr_ - rw + 7) * 32 + (4 * hi - qc + 15); const int vb_ = 4 * hi - c0w; float bv_[16]; \
        \
        \
      _Pragma("unroll") for (int r = 0; r < 16; ++r) { constexpr_cr(r); bv_[r] = bl_[cr_]; } \
      asm volatile("" : "+v"(bv_[0]), "+v"(bv_[1]), "+v"(bv_[2]), "+v"(bv_[3]), "+v"(bv_[4]), "+v"(bv_[5]), "+v"(bv_[6]), "+v"(bv_[7]), "+v"(bv_[8]), "+v"(bv_[9]), "+v"(bv_[10]), "+v"(bv_[11]), "+v"(bv_[12]), "+v"(bv_[13]), "+v"(bv_[14]), "+v"(bv_[15]) :: "memory"); \
      _Pragma("unroll") for (int r = 0; r < 16; ++r) { constexpr_cr(r); P0[r] = ((unsigned)(vb_ + cr_) < 16u) ? P0[r] + bv_[r] : -INFINITY; } \
      _Pragma("unroll") for (int r = 0; r < 16; ++r) { constexpr_cr(r); bv_[r] = bl_[cr_ + 32]; } \
      asm volatile("" : "+v"(bv_[0]), "+v"(bv_[1]), "+v"(bv_[2]), "+v"(bv_[3]), "+v"(bv_[4]), "+v"(bv_[5]), "+v"(bv_[6]), "+v"(bv_[7]), "+v"(bv_[8]), "+v"(bv_[9]), "+v"(bv_[10]), "+v"(bv_[11]), "+v"(bv_[12]), "+v"(bv_[13]), "+v"(bv_[14]), "+v"(bv_[15]) :: "memory"); \
      _Pragma("unroll") for (int r = 0; r < 16; ++r) { constexpr_cr(r); P1[r] = ((unsigned)(vb_ + cr_ + 32) < 16u) ? P1[r] + bv_[r] : -INFINITY; } } } } } while (0)
#define constexpr_cr(r) const int cr_ = ((r) & 3) + 8 * ((r) >> 2)
  f32x16 pA0, pA1, pB0, pB1; float alA, alB; bf16x8 pa0, pa1, pa2, pa3;
  SLOAD(0, 0); SWRITE(0, 0); __syncthreads();
  qkt<NKS>(pA0, pA1, K_lds, qr, negm, r32, hi); partialSM<true>(pA0, pA1, m_reg, negm, alA);
  SLOAD(1, 1); if (2 < NT) SLOAD(0, 2);
  SWRITE(1, 1); __syncthreads();
  for (int j = 1; j + 1 < NT; j += 2) {
    SBAR(); qkt<NKS>(pB0, pB1, K_lds + SHM_K, qr, negm, r32, hi); NAMASK(pB0, pB1, j);
    finishSM(pA0, pA1, alA, l_reg, pa0, pa1, pa2, pa3); SBAR();
    SLOAD(1, j + 2); SBAR();
    pv_all(o, vb0, pa0, pa1, pa2, pa3); partialSM<false>(pB0, pB1, m_reg, negm, alB);
    __syncthreads(); SWRITE(0, 0);
    RESC(alB); __syncthreads();
    SBAR(); qkt<NKS>(pA0, pA1, K_lds, qr, negm, r32, hi); NAMASK(pA0, pA1, j + 1);
    finishSM(pB0, pB1, alB, l_reg, pa0, pa1, pa2, pa3); SBAR();
    if (j + 3 < NT) SLOAD(0, j + 3); SBAR();
    pv_all(o, vb0 + SHM_V, pa0, pa1, pa2, pa3); partialSM<false>(pA0, pA1, m_reg, negm, alA);
    __syncthreads(); SWRITE(1, 1);
    RESC(alA); __syncthreads();
  }
  if (NA && (NT & 1)) {
    SBAR(); finishSM(pA0, pA1, alA, l_reg, pa0, pa1, pa2, pa3); SBAR();
    pv_all(o, vb0, pa0, pa1, pa2, pa3);
  } else {
  SBAR(); qkt<NKS>(pB0, pB1, K_lds + SHM_K, qr, negm, r32, hi); NAMASK(pB0, pB1, NT - 1);
  finishSM(pA0, pA1, alA, l_reg, pa0, pa1, pa2, pa3); SBAR();
  pv_all(o, vb0, pa0, pa1, pa2, pa3); partialSM<false>(pB0, pB1, m_reg, negm, alB);
  __syncthreads(); RESC(alB);
  finishSM(pB0, pB1, alB, l_reg, pa0, pa1, pa2, pa3); SBAR();
  pv_all(o, vb0 + SHM_V, pa0, pa1, pa2, pa3);
  }
  if (hi == 0) li_l[r32] = l_reg; asm volatile("s_waitcnt lgkmcnt(0)" ::: "memory");
  float rli[16];
#pragma unroll
  for (int r = 0; r < 16; ++r) rli[r] = __builtin_amdgcn_rcpf(li_l[crow(r, hi)]);
  { bf16_t* stg = (bf16_t*)(lds + L_OST) + wid * 2048;
#pragma unroll
    for (int r = 0; r < 16; ++r) { const int orow = crow(r, hi);
#pragma unroll
      for (int d0 = 0; d0 < 2; ++d0) stg[orow * 64 + d0 * 32 + r32] = (bf16_t)(cvtpk(o[d0][r] * rli[r], 0.f) & 0xffffu); }
    asm volatile("s_waitcnt lgkmcnt(0)" ::: "memory");
    bf16_t* Yw = T.Y + xrow0 * 1024 + (NA ? 512 : 0) + h * 64;
#pragma unroll
    for (int i = 0; i < 4; ++i) { const int row = i * 8 + (lane >> 3), ch = lane & 7; const u32x4 v = *(const u32x4*)(stg + row * 64 + ch * 8); *(u32x4*)(Yw + (size_t)row * 1024 + ch * 8) = v; } }
  __syncthreads();
#undef SLOAD
#undef SWRITE
#undef RESC
#undef NAMASK
#undef constexpr_cr
}
#undef KSWZ
#undef SBAR
}

__device__ __forceinline__ unsigned f2bf(float f) { return cvtpk(f, 0.f) & 0xffffu; }
enum RowMap { RM_ID = 0, RM_WIN, RM_WUQ, RM_WUKV, RM_GATE, RM_UP };
__device__ __forceinline__ int rowmap(int mode, int n) {
    switch (mode) {
    case RM_WIN: {
        if (n < 256) return 1280 + n;
        if (n < 384) return n - 256;
        if (n < 416) { const int d = n - 384; return 128 + (d < 16 ? 2 * d : 2 * (d - 16) + 1); }
        if (n < 1952) { const int jj = n - 416, w = jj >> 9, c = jj & 511; return (w == 0 ? 1536 : (w == 1 ? 256 : 768)) + c; }
        { const int g = n - 1952, c = g & 1023; return 2048 + (c >> 7) * 256 + (g >> 10) * 128 + (c & 127); }
    }
    case RM_WUQ: { const int h = n / 96, d = n % 96; if (d < 64) return n; const int dd = d - 64; return h * 96 + 64 + (dd < 16 ? 2 * dd : 2 * (dd - 16) + 1); }
    case RM_WUKV: { const int h = n >> 7, d = n & 127; return d < 64 ? h * 64 + d : 512 + h * 64 + (d - 64); }
    case RM_GATE: return (n >> 7) * 256 + (n & 127);
    case RM_UP: return (n >> 7) * 256 + 128 + (n & 127);
    default: return n;
    }
}
struct TItem { const float* W; bf16_t* WT; const float* kscale; int N, ldk, koff, mode, k0, n0; float scale; };
__device__ __forceinline__ void titem_set(TItem& D, const float* W, int N, bf16_t* WT, int ldk, int koff, int mode, const float* kscale, int item) {
    const int nblk = N / 32, kb = item / nblk, nb = item - kb * nblk;
    D.W = W; D.WT = WT; D.kscale = kscale; D.N = N; D.ldk = ldk; D.koff = koff; D.mode = mode; D.k0 = 64 * kb; D.n0 = 32 * nb;
    D.scale = (mode == RM_WIN && D.n0 >= 1952) ? -LOG2E : (mode == RM_GATE ? LOG2E : (mode == RM_UP ? LN2_F : 1.f));
}
__device__ __forceinline__ void titem_issue(const TItem& D, float (&xn)[32], int lane) {
    const float* p = D.W + (size_t)(D.k0 + (lane >> 5)) * D.N + D.n0 + (lane & 31);
#pragma unroll
    for (int i = 0; i < 32; ++i) xn[i] = __builtin_nontemporal_load(p + (size_t)(2 * i) * D.N);
    asm volatile("" ::: "memory");
}
__device__ __forceinline__ void titem_consume(const TItem& D, float (&xn)[32], float (&v)[32], int lane) {
    asm volatile("" : "+v"(xn[0]), "+v"(xn[1]), "+v"(xn[2]), "+v"(xn[3]), "+v"(xn[4]), "+v"(xn[5]), "+v"(xn[6]), "+v"(xn[7]), "+v"(xn[8]), "+v"(xn[9]), "+v"(xn[10]), "+v"(xn[11]), "+v"(xn[12]), "+v"(xn[13]), "+v"(xn[14]), "+v"(xn[15]) :: "memory");
    asm volatile("" : "+v"(xn[16]), "+v"(xn[17]), "+v"(xn[18]), "+v"(xn[19]), "+v"(xn[20]), "+v"(xn[21]), "+v"(xn[22]), "+v"(xn[23]), "+v"(xn[24]), "+v"(xn[25]), "+v"(xn[26]), "+v"(xn[27]), "+v"(xn[28]), "+v"(xn[29]), "+v"(xn[30]), "+v"(xn[31]) :: "memory");
#pragma unroll
    for (int i = 0; i < 32; ++i) v[i] = xn[i] * D.scale;
    if (D.kscale) {
#pragma unroll
        for (int i = 0; i < 32; ++i) v[i] *= D.kscale[D.k0 + 2 * i + (lane >> 5)]; }
}
__device__ __forceinline__ void titem_body(const TItem& D, const float (&v)[32], LAS float* scr, int lane) {
#pragma unroll
    for (int i = 0; i < 32; ++i) scr[(2 * i + (lane >> 5)) * 33 + (lane & 31)] = v[i];
    LDS_WAIT(); asm volatile("" ::: "memory");
    const int c = lane & 7;
#pragma unroll
    for (int j = 0; j < 4; ++j) { const int n = (lane >> 3) + 8 * j; const LAS float* s = scr + (8 * c) * 33 + n;
        u32x4 o; o.x = cvtpk(s[0 * 33], s[1 * 33]); o.y = cvtpk(s[2 * 33], s[3 * 33]); o.z = cvtpk(s[4 * 33], s[5 * 33]); o.w = cvtpk(s[6 * 33], s[7 * 33]);
        __builtin_nontemporal_store(o, (u32x4*)(D.WT + (size_t)rowmap(D.mode, D.n0 + n) * D.ldk + D.koff + D.k0 + 8 * c)); }
    LDS_WAIT(); asm volatile("" ::: "memory");
}
constexpr int NWEG_P3 = 2304;
enum { I_X = 0, I_C, I_CTX, I_CCTX, I_WMOD, I_BMOD, I_WIN, I_QG, I_WUQ, I_KVG, I_WUKV, I_BIAS, I_WPM, I_WPN, I_WOUT, I_LN1G, I_LN1B, I_WR, I_WEG, I_WEU, I_WED, I_LN2G, I_LN2B };

__device__ __forceinline__ void p0_prologue(Frame& F) {
    unsigned char* ws = F.ws;
    if (F.vcu < 192) {
        LAS float* S = (LAS float*)(F.lds);
        LAS float* red = (LAS float*)(F.lds + 9 * 1024 * 4);
        const int kq = F.tid >> 5, nn = F.tid & 31, n0 = F.vcu * 32;
        float w[64], cv[18];
        { const float* wm = F.in[I_WMOD] + n0 + nn + (size_t)(kq * 64) * 6144;
#pragma unroll
          for (int j = 0; j < 64; ++j) w[j] = __builtin_nontemporal_load(wm + (size_t)j * 6144); }
#pragma unroll
        for (int j = 0; j < 18; ++j) cv[j] = (j < 16) ? F.in[I_C][F.tid + 512 * j] : F.in[I_CCTX][F.tid + 512 * (j - 16)];
#pragma unroll
        for (int j = 0; j < 18; ++j) { const float v = cv[j]; S[F.tid + 512 * j] = v / (1.f + __expf(-v)); }
        __syncthreads();
        float a[9];
#pragma unroll
        for (int r = 0; r < 9; ++r) a[r] = 0.f;
#pragma unroll
        for (int j4 = 0; j4 < 16; ++j4)
#pragma unroll
            for (int r = 0; r < 9; ++r) { const f32x4 sv = *(const LAS f32x4*)(S + r * 1024 + kq * 64 + j4 * 4);
                a[r] += sv[0] * w[j4 * 4 + 0]; a[r] += sv[1] * w[j4 * 4 + 1]; a[r] += sv[2] * w[j4 * 4 + 2]; a[r] += sv[3] * w[j4 * 4 + 3]; }
#pragma unroll
        for (int r = 0; r < 9; ++r) red[(kq * 9 + r) * 32 + nn] = a[r];
        __syncthreads();
        if (F.tid < 288) { const int r = F.tid >> 5; float s = F.in[I_BMOD][n0 + nn];
            for (int q = 0; q < 16; ++q) s += red[(q * 9 + r) * 32 + nn];
            ((float*)(ws + WS_MOD))[r * 6144 + n0 + nn] = s; }
        asm volatile("s_waitcnt vmcnt(0)" ::: "memory");
        __syncthreads();
        if (F.tid == 0) { __builtin_amdgcn_fence(__ATOMIC_RELEASE, "agent"); asm volatile("s_waitcnt vmcnt(0)" ::: "memory"); (void)xb_add((unsigned*)(ws + WS_CTL) + CW_MODFLAG, 1u); }
    }
    if (F.vcu == 255 && F.tid < 512) { const int p = F.tid >> 3, f = F.tid & 7; const float inv = powf(10000.f, -(float)f / 8.f), ang = (float)p * inv;
        float* rp = (float*)(ws + WS_ROPE); rp[p * 8 + f] = cosf(ang); rp[512 + p * 8 + f] = sinf(ang); }
    { const int gt = F.vcu * 512 + F.tid, NGT = F.G * 512;
      u32x4 z = {0u, 0u, 0u, 0u};
      for (int i = gt; i < 96 * 128; i += NGT) *(u32x4*)(ws + WS_WIN + (size_t)160 * 2048 + (size_t)i * 16) = z;
      for (int i = gt; i < 1024 * 16; i += NGT) { const int row = i >> 4, ch = i & 15; *(u32x4*)(ws + WS_WUKV + (size_t)row * 512 + 256 + ch * 16) = z; } }
    LAS float* scr = (LAS float*)(F.lds + F.wave * 16384);
    const int gw = F.vcu * NWAVES + F.wave, NGW = F.G * NWAVES;
    constexpr int I_IN = 16 * 125, I_UQ = 4 * 24, I_UKV = 2 * 32, I_PR = 8 * 32, I_OUT = 16 * 32, I_EX = 16 * 32;
    constexpr int NSMALL = I_IN + I_UQ + I_UKV + 2 * I_PR + I_OUT;
    constexpr int NITEMS = NSMALL + 16 * I_EX - NWEG_P3;
    auto decode = [&](TItem& D, const int it) __attribute__((always_inline)) {
        int r = it;
        if (r < I_IN) { titem_set(D, F.in[I_WIN], D_IN, (bf16_t*)(ws + WS_WIN), 1024, 0, RM_WIN, nullptr, r); return; } r -= I_IN;
        if (r < I_UQ) { titem_set(D, F.in[I_WUQ], 768, (bf16_t*)(ws + WS_WUQ), 256, 0, RM_WUQ, F.in[I_QG], r); return; } r -= I_UQ;
        if (r < I_UKV) { titem_set(D, F.in[I_WUKV], 1024, (bf16_t*)(ws + WS_WUKV), 256, 0, RM_WUKV, F.in[I_KVG], r); return; } r -= I_UKV;
        if (r < I_PR) { titem_set(D, F.in[I_WPM], 1024, (bf16_t*)(ws + WS_WPROJ), 1024, 0, RM_ID, nullptr, r); return; } r -= I_PR;
        if (r < I_PR) { titem_set(D, F.in[I_WPN], 1024, (bf16_t*)(ws + WS_WPROJ), 1024, 512, RM_ID, nullptr, r); return; } r -= I_PR;
        if (r < I_OUT) { titem_set(D, F.in[I_WOUT], 1024, (bf16_t*)(ws + WS_WOUT), 1024, 0, RM_ID, nullptr, r); return; } r -= I_OUT;
        r += NWEG_P3; const int e = r / I_EX, ii = r % I_EX;
        titem_set(D, F.in[I_WEG] + (size_t)e * 1024 * 1024, 1024, (bf16_t*)(ws + WS_WGU) + (size_t)e * 2048 * 1024, 1024, 0, RM_GATE, nullptr, ii);
    };
    if (gw < NITEMS) {
        TItem Dc, Dn; float xn[32], v[32];
        decode(Dc, gw); titem_issue(Dc, xn, F.lane); titem_consume(Dc, xn, v, F.lane);
        int it = gw;
        for (; it + NGW < NITEMS; it += NGW) { decode(Dn, it + NGW); titem_issue(Dn, xn, F.lane); titem_body(Dc, v, scr, F.lane); titem_consume(Dn, xn, v, F.lane); Dc = Dn; }
        titem_body(Dc, v, scr, F.lane);
    }
}

__device__ __forceinline__ void p1_adaln(Frame& F) {
    const int gw = F.vcu * NWAVES + F.wave, G = F.G, lane = F.lane;
    const float* mod = (const float*)(F.ws + WS_MOD); bf16_t* U = (bf16_t*)(F.ws + WS_U);
    const int b = gw / G, r0 = gw - b * G;
    auto run = [&](const int j0, const int j1, const float* mr, const float* src0) __attribute__((always_inline)) {
        if (j0 >= j1) return;
        f32x4 sh[4], sc[4], v[4], xn[4];
#pragma unroll
        for (int q = 0; q < 4; ++q) { sh[q] = *((const f32x4*)mr + lane + 64 * q); sc[q] = *((const f32x4*)(mr + 1024) + lane + 64 * q) + 1.f; }
#define P1_ISSUE(j) do { const f32x4* xr_ = (const f32x4*)(src0 + (size_t)(j) * DM) + lane; \
            _Pragma("unroll") for (int q = 0; q < 4; ++q) xn[q] = __builtin_nontemporal_load(xr_ + 64 * q); asm volatile("" ::: "memory"); } while (0)
#define P1_CONSUME() do { asm volatile("" : "+v"(xn[0]), "+v"(xn[1]), "+v"(xn[2]), "+v"(xn[3]) :: "memory"); _Pragma("unroll") for (int q = 0; q < 4; ++q) v[q] = xn[q]; } while (0)
#define P1_BODY(j) do { float s = 0.f; \
            _Pragma("unroll") for (int q = 0; q < 4; ++q) s += (v[q][0] + v[q][1]) + (v[q][2] + v[q][3]); \
            const float mean = wave_sum(s) * (1.f / DM); float s2 = 0.f; \
            _Pragma("unroll") for (int q = 0; q < 4; ++q) { v[q] = v[q] - mean; s2 += (v[q][0] * v[q][0] + v[q][1] * v[q][1]) + (v[q][2] * v[q][2] + v[q][3] * v[q][3]); } \
            const float rstd = 1.f / sqrtf(wave_sum(s2) * (1.f / DM) + LN_EPS); \
            u32x2* o8 = (u32x2*)(U + ((size_t)b * SCOMB + (j)) * DM) + lane; \
            _Pragma("unroll") for (int q = 0; q < 4; ++q) { const f32x4 y = v[q] * rstd * sc[q] + sh[q]; u32x2 w; w.x = cvtpk(y[0], y[1]); w.y = cvtpk(y[2], y[3]); o8[64 * q] = w; } } while (0)
        P1_ISSUE(j0); P1_CONSUME();
        int j = j0;
        for (; j + G < j1; j += G) { P1_ISSUE(j + G); P1_BODY(j); P1_CONSUME(); }
        P1_BODY(j);
#undef P1_ISSUE
#undef P1_CONSUME
#undef P1_BODY
    };
    run(r0, CTXL, mod + 8 * 6144, F.in[I_CTX] + (size_t)b * CTXL * DM);
    const int jl = r0 + ((CTXL - r0 + G - 1) / G) * G;
    run(r0 >= CTXL ? r0 : jl, SCOMB, mod + b * 6144, F.in[I_X] + ((ptrdiff_t)b * SEQ - CTXL) * DM);
}

__device__ __forceinline__ unsigned pkh(float a, float b) { return __builtin_bit_cast(unsigned, __builtin_amdgcn_cvt_pkrtz(a, b)); }
__device__ __forceinline__ float hlo(unsigned w) { return (float)__builtin_bit_cast(h16x2, w)[0]; }
__device__ __forceinline__ float hhi(unsigned w) { return (float)__builtin_bit_cast(h16x2, w)[1]; }
__device__ __forceinline__ void p7_ln_router(Frame& F) {
    LAS f32x4* Wl = (LAS f32x4*)F.lds;
    for (int i = F.tid; i < 1024 * 4; i += 512) { const int c = i >> 2, e4 = i & 3, l = (c & 255) >> 2, k = c & 3, j = c >> 8;
        Wl[((j * 4 + k) * 4 + e4) * 64 + l] = *(const f32x4*)(F.in[I_WR] + (size_t)c * 16 + e4 * 4); }
    __syncthreads();
    const int gw = F.vcu * NWAVES + F.wave, NGW = F.G * NWAVES, lane = F.lane;
    const float* mod = (const float*)(F.ws + WS_MOD); bf16_t* U2 = (bf16_t*)(F.ws + WS_U2); float* AFF = (float*)(F.ws + WS_AFF); const bf16_t* MIXR = (const bf16_t*)(F.ws + WS_MIXR);
    f32x4 g1[4], b1[4];
#pragma unroll
    for (int q = 0; q < 4; ++q) { g1[q] = *((const f32x4*)F.in[I_LN1G] + lane + 64 * q); b1[q] = *((const f32x4*)F.in[I_LN1B] + lane + 64 * q); }
    const int b = gw / F.G, r0 = gw - b * F.G;
    const float* mr = mod + b * 6144;
    f32x4 g1m[4], sh2[4], sc2[4];
#pragma unroll
    for (int q = 0; q < 4; ++q) { g1m[q] = *((const f32x4*)(mr + 2 * 1024) + lane + 64 * q); sh2[q] = *((const f32x4*)(mr + 3 * 1024) + lane + 64 * q); sc2[q] = *((const f32x4*)(mr + 4 * 1024) + lane + 64 * q) + 1.f; }
    f32x4 xn[4]; u32x2 wn[4]; f32x4 v[4];
#define P7_ISSUE(mm) do { const f32x4* xin_ = (const f32x4*)(F.in[I_X] + (size_t)(mm) * DM) + lane; const u32x2* mxr_ = (const u32x2*)(MIXR + (size_t)(mm) * DM) + lane; \
        _Pragma("unroll") for (int q = 0; q < 4; ++q) { xn[q] = __builtin_nontemporal_load(xin_ + 64 * q); wn[q] = __builtin_nontemporal_load(mxr_ + 64 * q); } asm volatile("" ::: "memory"); } while (0)
#define P7_CONSUME() do { asm volatile("" : "+v"(xn[0]), "+v"(xn[1]), "+v"(xn[2]), "+v"(xn[3]), "+v"(wn[0]), "+v"(wn[1]), "+v"(wn[2]), "+v"(wn[3]) :: "memory");     \
        _Pragma("unroll") for (int q = 0; q < 4; ++q) { const f32x4 xv = xn[q]; const u32x2 w = wn[q]; const f32x4 g1v = g1m[q]; \
            v[q][0] = xv[0] * ALPHA + g1v[0] * bflo(w.x); v[q][1] = xv[1] * ALPHA + g1v[1] * bfhi(w.x); v[q][2] = xv[2] * ALPHA + g1v[2] * bflo(w.y); v[q][3] = xv[3] * ALPHA + g1v[3] * bfhi(w.y); } } while (0)
    auto body = [&](const int m) __attribute__((always_inline)) {
        u32x2* mxr = (u32x2*)(MIXR + (size_t)m * DM) + lane;
        float s = 0.f;
#pragma unroll
        for (int q = 0; q < 4; ++q) s += (v[q][0] + v[q][1]) + (v[q][2] + v[q][3]);
        float mean = wave_sum(s) * (1.f / DM), s2 = 0.f;
#pragma unroll
        for (int q = 0; q < 4; ++q) { v[q] = v[q] - mean; s2 += (v[q][0] * v[q][0] + v[q][1] * v[q][1]) + (v[q][2] * v[q][2] + v[q][3] * v[q][3]); }
        float rstd = __builtin_amdgcn_rsqf(wave_sum(s2) * (1.f / DM) + LN_EPS);
        s = 0.f;
#pragma unroll
        for (int q = 0; q < 4; ++q) { v[q] = v[q] * rstd * g1[q] + b1[q]; s += (v[q][0] + v[q][1]) + (v[q][2] + v[q][3]);
            u32x2 w; w.x = pkh(v[q][0], v[q][1]); w.y = pkh(v[q][2], v[q][3]); ((u32x2*)mxr)[64 * q] = w; }
        mean = wave_sum(s) * (1.f / DM); s2 = 0.f;
#pragma unroll
        for (int q = 0; q < 4; ++q) { v[q] = v[q] - mean; s2 += (v[q][0] * v[q][0] + v[q][1] * v[q][1]) + (v[q][2] * v[q][2] + v[q][3] * v[q][3]); }
        rstd = __builtin_amdgcn_rsqf(wave_sum(s2) * (1.f / DM) + LN_EPS);
        u32x2* o8 = (u32x2*)(U2 + (size_t)m * DM) + lane;
        f32x2 lg2[8];
#pragma unroll
        for (int e = 0; e < 8; ++e) lg2[e] = (f32x2){0.f, 0.f};
#pragma unroll
        for (int q = 0; q < 4; ++q) {
            const f32x4 y = v[q] * rstd * sc2[q] + sh2[q]; u32x2 w; w.x = cvtpk(y[0], y[1]); w.y = cvtpk(y[2], y[3]); o8[64 * q] = w;
#pragma unroll
            for (int k = 0; k < 4; ++k) { const f32x2 yy = {y[k], y[k]};
#pragma unroll
                for (int e4 = 0; e4 < 4; ++e4) { const f32x4 wv = Wl[((q * 4 + k) * 4 + e4) * 64 + lane];
                    lg2[e4 * 2 + 0] = __builtin_elementwise_fma(yy, (f32x2){wv[0], wv[1]}, lg2[e4 * 2 + 0]); lg2[e4 * 2 + 1] = __builtin_elementwise_fma(yy, (f32x2){wv[2], wv[3]}, lg2[e4 * 2 + 1]); } }
            asm volatile("" ::: "memory"); }
        float lg[16];
#pragma unroll
        for (int e = 0; e < 8; ++e) { lg[2 * e] = lg2[e][0]; lg[2 * e + 1] = lg2[e][1]; }
        float r8[8], r4[4], r2[2], r1;
#pragma unroll
        for (int i = 0; i < 8; ++i) { auto q_ = __builtin_amdgcn_permlane32_swap(__float_as_uint(lg[i]), __float_as_uint(lg[i + 8]), false, false); r8[i] = __uint_as_float(q_[0]) + __uint_as_float(q_[1]); }
#pragma unroll
        for (int i = 0; i < 4; ++i) { auto q_ = __builtin_amdgcn_permlane16_swap(__float_as_uint(r8[i]), __float_as_uint(r8[i + 4]), false, false); r4[i] = __uint_as_float(q_[0]) + __uint_as_float(q_[1]); }
        { const bool up = (lane & 8) != 0;
#pragma unroll
          for (int i = 0; i < 2; ++i) { const float snd = up ? r4[i] : r4[i + 2], keep = up ? r4[i + 2] : r4[i]; r2[i] = keep + dppf<DPP_ROR8>(snd); } }
        { const bool up = (lane & 4) != 0; const float snd = up ? r2[0] : r2[1], keep = up ? r2[1] : r2[0]; r1 = keep + lane_xor4(snd); }
        r1 += dppf<DPP_XOR2>(r1); r1 += dppf<DPP_XOR1>(r1);
        const float mx = wave_max_q(r1);
        const float ex = __builtin_amdgcn_exp2f((r1 - mx) * LOG2E); const float sm = wave_sum_q(ex);
        AFF[(size_t)m * 16 + (lane >> 2)] = ex * __builtin_amdgcn_rcpf(sm);
    };
    const int nr = (r0 < SEQ) ? (SEQ - r0 + F.G - 1) / F.G : 0, m0 = b * SEQ + r0;
    if (nr > 0) {
        P7_ISSUE(m0); P7_CONSUME();
        for (int i = 0; i + 1 < nr; ++i) { P7_ISSUE(m0 + (i + 1) * F.G); body(m0 + i * F.G); P7_CONSUME(); }
        body(m0 + (nr - 1) * F.G);
    }
#undef P7_ISSUE
#undef P7_CONSUME
}

__device__ __forceinline__ int block_exscan(int v, LAS int* wsum, int tid, int lane, int wave, int& total) {
    int inc = v;
#pragma unroll
    for (int o = 1; o < 64; o <<= 1) { const int t = __shfl_up(inc, o); if (lane >= o) inc += t; }
    __syncthreads();
    if (lane == 63) wsum[wave] = inc;
    __syncthreads();
    int pre = 0, tot = 0;
#pragma unroll
    for (int w = 0; w < NWAVES; ++w) { const int s = wsum[w]; if (w < wave) pre += s; tot += s; }
    total = tot;
    return pre + inc - v;
}
__device__ __forceinline__ void p8_topk_gather(Frame& F) {
    if ((F.vcu & 1) || F.vcu >= 256) {
        const int cw = (F.vcu >> 1) * NWAVES + F.wave, NCW = (F.G >> 1) * NWAVES;
        constexpr int NIT = 16 * 16 * 32;
        if ((F.vcu & 1) && cw < NIT) {
            LAS float* scr = (LAS float*)(F.lds + F.wave * 16384);
            auto dec = [&](TItem& D, const int it) __attribute__((always_inline)) { const int e = it >> 9, ii = it & 511;
                titem_set(D, F.in[I_WED] + (size_t)e * 1024 * 1024, 1024, (bf16_t*)(F.ws + WS_WD) + (size_t)e * 1024 * 1024, 1024, 0, RM_ID, nullptr, ii); };
            TItem Dc, Dn; float xn[32], v[32];
            dec(Dc, cw); titem_issue(Dc, xn, F.lane); titem_consume(Dc, xn, v, F.lane);
            int it = cw;
            for (; it + NCW < NIT; it += NCW) { dec(Dn, it + NCW); titem_issue(Dn, xn, F.lane); titem_body(Dc, v, scr, F.lane); titem_consume(Dn, xn, v, F.lane); Dc = Dn; }
            titem_body(Dc, v, scr, F.lane);
        }
        return;
    }
    const int tk = F.vcu >> 1, e = tk >> 3, b = tk & 7, tid = F.tid, lane = F.lane, wave = F.wave;
    LAS int* wsum = (LAS int*)(F.lds + 1024);
    const float* AFF = (const float*)(F.ws + WS_AFF) + (size_t)b * SEQ * 16 + e;
    unsigned key[8];
#pragma unroll
    for (int k = 0; k < 8; ++k) key[k] = __float_as_uint(AFF[(size_t)(tid * 8 + k) * 16]);
    LAS int* cbuf = (LAS int*)(F.lds + 2048);
    unsigned prefix = 0u, need = CAP;
#pragma unroll 1
    for (int bit = 30; bit >= -1; --bit) {
        const unsigned cand = (bit >= 0) ? (prefix | (1u << bit)) : (prefix + 1u);
        int cw = 0;
#pragma unroll
        for (int k = 0; k < 8; ++k) cw += __builtin_popcountll(__ballot(key[k] >= cand));
        const int par_ = bit & 1;
        if (lane == 0) cbuf[par_ * 8 + wave] = cw;
        __syncthreads();
        int tot = 0;
#pragma unroll
        for (int w = 0; w < NWAVES; ++w) tot += cbuf[par_ * 8 + w];
        if (bit >= 0) { if (tot >= CAP) prefix = cand; } else need = (unsigned)(CAP - tot);
    }
    __syncthreads();
    int ceq = 0;
#pragma unroll
    for (int k = 0; k < 8; ++k) ceq += (key[k] == prefix) ? 1 : 0;
    int tot; int req = block_exscan(ceq, wsum, tid, lane, wave, tot);
    int csel = 0; unsigned selm = 0u;
#pragma unroll
    for (int k = 0; k < 8; ++k) { bool s = key[k] > prefix; if (key[k] == prefix) { s = (unsigned)req < need; ++req; } if (s) { selm |= 1u << k; ++csel; } }
    int slot = block_exscan(csel, wsum, tid, lane, wave, tot);
    float* GV = (float*)(F.ws + WS_GV) + (size_t)tk * CAP; int* INV = (int*)(F.ws + WS_INV) + (size_t)b * SEQ * 16 + e; int* IDX = (int*)(F.ws + WS_IDX) + (size_t)tk * CAP;
#pragma unroll
    for (int k = 0; k < 8; ++k) { const int t = tid * 8 + k; const bool s = (selm >> k) & 1u;
        if (s && slot < CAP) { IDX[slot] = b * SEQ + t; GV[slot] = __uint_as_float(key[k]); }
        INV[(size_t)t * 16] = s ? slot : -1;
        if (s) ++slot; }
    __syncthreads();
}

__device__ __forceinline__ void p11_final(Frame& F) {
    const int gw = F.vcu * NWAVES + F.wave, lane = F.lane, G = F.G;
    const float* mod = (const float*)(F.ws + WS_MOD); const bf16_t* YE = (const bf16_t*)(F.ws + WS_YE); const int* INV = (const int*)(F.ws + WS_INV); const bf16_t* X1H = (const bf16_t*)(F.ws + WS_MIXR);
    const int b = gw / G, r0 = gw - b * G;
    const float* mr = mod + b * 6144;
    f32x4 g2m[4], g2l[4], b2l[4];
#pragma unroll
    for (int q = 0; q < 4; ++q) { g2m[q] = *((const f32x4*)(mr + 5 * 1024) + lane + 64 * q); g2l[q] = *((const f32x4*)F.in[I_LN2G] + lane + 64 * q); b2l[q] = *((const f32x4*)F.in[I_LN2B] + lane + 64 * q); }
    const bf16_t* YEb = YE + (size_t)b * CAP * DM; const bf16_t* ZROW = (const bf16_t*)(F.ws + WS_ZROW);
    LAS int* sl = (LAS int*)F.lds + F.wave * 1024;
    u32x2 wn[4], y[4][4]; int slotc = -1; unsigned mrest = 0u;
    f32x4 v[4], mo[4];
#define P11_ISSUE(mm, li) do { slotc = sl[(li) * 16 + (lane & 15)]; { const u32x2* mxr_ = (const u32x2*)(X1H + (size_t)(mm) * DM) + lane; \
        _Pragma("unroll") for (int q = 0; q < 4; ++q) wn[q] = __builtin_nontemporal_load(mxr_ + 64 * q); } \
        unsigned mk_ = (unsigned)(__ballot(slotc >= 0) & 0xFFFFull); \
        _Pragma("unroll") for (int k = 0; k < 4; ++k) { const bool has_ = mk_ != 0u; const int e_ = has_ ? __builtin_ctz(mk_) : 0; mk_ &= mk_ - 1u; if (!has_) mk_ = 0u; const int s_ = __builtin_amdgcn_readlane(slotc, e_); \
            const u32x2* y_ = (const u32x2*)(has_ ? YEb + ((size_t)(e_ * 8) * CAP + s_) * DM : ZROW) + lane; _Pragma("unroll") for (int q = 0; q < 4; ++q) y[k][q] = y_[64 * q]; } \
        mrest = mk_; asm volatile("" ::: "memory"); } while (0)
#define P11_CONSUME() do { asm volatile("" ::: "memory"); \
        _Pragma("unroll") for (int q = 0; q < 4; ++q) { const u32x2 w = wn[q]; v[q][0] = hlo(w.x); v[q][1] = hhi(w.x); v[q][2] = hlo(w.y); v[q][3] = hhi(w.y); \
            mo[q][0] = bflo(y[0][q].x); mo[q][1] = bfhi(y[0][q].x); mo[q][2] = bflo(y[0][q].y); mo[q][3] = bfhi(y[0][q].y); \
            _Pragma("unroll") for (int k = 1; k < 4; ++k) { mo[q][0] += bflo(y[k][q].x); mo[q][1] += bfhi(y[k][q].x); mo[q][2] += bflo(y[k][q].y); mo[q][3] += bfhi(y[k][q].y); } } \
        while (mrest) { const int e0 = __builtin_ctz(mrest); mrest &= mrest - 1; const int s0 = __builtin_amdgcn_readlane(slotc, e0); \
            const u32x2* y0 = (const u32x2*)(YEb + ((size_t)(e0 * 8) * CAP + s0) * DM) + lane; u32x2 ya[4]; \
            _Pragma("unroll") for (int q = 0; q < 4; ++q) ya[q] = y0[64 * q]; \
            _Pragma("unroll") for (int q = 0; q < 4; ++q) { mo[q][0] += bflo(ya[q].x); mo[q][1] += bfhi(ya[q].x); mo[q][2] += bflo(ya[q].y); mo[q][3] += bfhi(ya[q].y); } } } while (0)
#define P11_FINISH(mm) do { f32x4* orow = (f32x4*)(F.out + (size_t)(mm) * DM) + lane; float s = 0.f; \
        _Pragma("unroll") for (int q = 0; q < 4; ++q) { v[q] = v[q] * ALPHA + g2m[q] * mo[q]; s += (v[q][0] + v[q][1]) + (v[q][2] + v[q][3]); } \
        const float mean = wave_sum(s) * (1.f / DM); float s2 = 0.f; \
        _Pragma("unroll") for (int q = 0; q < 4; ++q) { v[q] = v[q] - mean; s2 += (v[q][0] * v[q][0] + v[q][1] * v[q][1]) + (v[q][2] * v[q][2] + v[q][3] * v[q][3]); } \
        const float rstd = 1.f / sqrtf(wave_sum(s2) * (1.f / DM) + LN_EPS); \
        _Pragma("unroll") for (int q = 0; q < 4; ++q) __builtin_nontemporal_store(v[q] * rstd * g2l[q] + b2l[q], orow + 64 * q); } while (0)
    for (int c0 = r0; c0 < SEQ; c0 += 64 * G) {
        const int nr = min(64, (SEQ - c0 + G - 1) / G), mc = b * SEQ + c0;
        for (int i0 = 0; i0 < nr; i0 += 16) { int t_[4];
#pragma unroll
            for (int j = 0; j < 4; ++j) { const int i = i0 + 4 * j + (lane >> 4); t_[j] = (i < nr) ? INV[(size_t)(mc + i * G) * 16 + (lane & 15)] : -1; }
#pragma unroll
            for (int j = 0; j < 4; ++j) { const int i = i0 + 4 * j + (lane >> 4); sl[i * 16 + (lane & 15)] = t_[j]; } }
        __builtin_amdgcn_fence(__ATOMIC_RELEASE, "wavefront"); __builtin_amdgcn_wave_barrier(); __builtin_amdgcn_fence(__ATOMIC_ACQUIRE, "wavefront");
        P11_ISSUE(mc, 0); P11_CONSUME();
        for (int i = 0; i + 1 < nr; ++i) {
            P11_ISSUE(mc + (i + 1) * G, i + 1);
            P11_FINISH(mc + i * G);
            P11_CONSUME();
        }
        P11_FINISH(mc + (nr - 1) * G);
        __builtin_amdgcn_wave_barrier();
    }
#undef P11_ISSUE
#undef P11_CONSUME
#undef P11_FINISH
}

constexpr int N_PHASES = 12;
struct Args { const float* in[23]; float* out; unsigned char* ws; int ph_lo, ph_hi, rep, pad; };
__global__ void __launch_bounds__(NWAVES * 64, 2) fwd_mega(Args args) {
    extern __shared__ __attribute__((aligned(16))) unsigned char lds[];
    Frame F;
    F.lds = (LAS unsigned char*)lds;
    F.MISC = (volatile LAS unsigned*)(F.lds + MISC_OFF);
    F.tid = threadIdx.x; F.lane = F.tid & 63; F.wave = __builtin_amdgcn_readfirstlane(F.tid >> 6);
    F.G = gridDim.x; { const int bx = blockIdx.x; F.vcu = (bx % 8) * (F.G / 8) + bx / 8; }
    F.ws = args.ws; F.out = args.out;
#pragma unroll
    for (int i = 0; i < 23; ++i) F.in[i] = args.in[i];
    unsigned char* ws = args.ws;
    for (int u = F.tid; u < (LDS_BYTES - LDSCTL_OFF) / 4; u += NWAVES * 64) ((LAS unsigned*)(F.lds + LDSCTL_OFF))[u] = 0u;
    __syncthreads();
    XcdBarrier bar; bar.bar = (unsigned*)(ws + WS_CTL) + CW_BAR; bar.x = 0; bar.st = nullptr;
    if (MK_N_LAUNCHES == 1) bar = xcd_barrier_post((unsigned*)(ws + WS_CTL) + CW_BAR, F.MISC + 8);
    const int lo = args.ph_lo, hi = args.ph_hi;
#define IN(k) (lo <= (k) && (k) < hi)
#define SEAM(k) do { if (IN(k) && IN((k) + 1)) xcd_barrier(bar); } while (0)
    float* ssq_kv = (float*)(ws + WS_SSQ); float* ssq_q = ssq_kv + MC;
    const float* rope = (const float*)(ws + WS_ROPE);

    if (((MK_PHASE_MASK >> 0) & 1) && IN(0)) { p0_prologue(F); }
    if (IN(1)) {
        if (F.tid == 0) { unsigned* fl = (unsigned*)(ws + WS_CTL) + CW_MODFLAG; XB_SPIN(xb_ld(fl) < 192u, (unsigned*)(ws + WS_CTL) + CW_BAR); __builtin_amdgcn_fence(__ATOMIC_ACQUIRE, "agent"); asm volatile("s_waitcnt vmcnt(0)" ::: "memory"); }
        __syncthreads();
    }
    if (((MK_PHASE_MASK >> 1) & 1) && IN(1)) { p1_adaln(F); } SEAM(1);
    if (((MK_PHASE_MASK >> 2) & 1) && IN(2)) {
        SchedInProj S{F.G, (int)blockIdx.x};
        EpiInProj E{(bf16_t*)(ws + WS_KVX), (bf16_t*)(ws + WS_NK), (bf16_t*)(ws + WS_NV), (bf16_t*)(ws + WS_QC), (bf16_t*)(ws + WS_NQ), (bf16_t*)(ws + WS_GATES), ssq_kv, ssq_q, rope, args.rep ? 0.f : 1.f};
        pg8::gemm_phase<EpiInProj, SchedInProj, true>(F.lds + RING_OFF, (const bf16_t*)(ws + WS_U), (const bf16_t*)(ws + WS_WIN), 1024, S, E);
        if ((int)blockIdx.x >= 40 && F.G > 40) {
            asm volatile("s_waitcnt vmcnt(0)" ::: "memory"); __syncthreads();
            const int cw = ((int)blockIdx.x - 40) * NWAVES + F.wave, NCW = (F.G - 40) * NWAVES;
            constexpr int NIT = 16 * 512;
            if (cw < NIT) {
                LAS float* scr = (LAS float*)(F.lds + F.wave * 16384);
                auto dec = [&](TItem& D, const int it) __attribute__((always_inline)) { const int e = it >> 9, ii = it & 511;
                    titem_set(D, F.in[I_WEU] + (size_t)e * 1024 * 1024, 1024, (bf16_t*)(ws + WS_WGU) + (size_t)e * 2048 * 1024, 1024, 0, RM_UP, nullptr, ii); };
                TItem Dc, Dn; float xn[32], v[32];
                dec(Dc, cw); titem_issue(Dc, xn, F.lane); titem_consume(Dc, xn, v, F.lane);
                int it = cw;
                for (; it + NCW < NIT; it += NCW) { dec(Dn, it + NCW); titem_issue(Dn, xn, F.lane); titem_body(Dc, v, scr, F.lane); titem_consume(Dn, xn, v, F.lane); Dc = Dn; }
                titem_body(Dc, v, scr, F.lane);
            }
        }
    } SEAM(2);
    if (((MK_PHASE_MASK >> 3) & 1) && IN(3)) {
        SchedUp S{F.G, F.vcu}; EpiUp E{EpiQUp{(bf16_t*)(ws + WS_QM), ssq_q, rope}, EpiKVUp{(bf16_t*)(ws + WS_KMN), (bf16_t*)(ws + WS_VM), ssq_kv}};
        pg8::gemm_phase<EpiUp, SchedUp, true>(F.lds + RING_OFF, (const bf16_t*)(ws + WS_QC), (const bf16_t*)(ws + WS_WUQ), 256, S, E);
        if (F.vcu >= 928 - 3 * F.G && F.G == 256) {
            asm volatile("s_waitcnt vmcnt(0)" ::: "memory"); __syncthreads();
            const int cw = (F.vcu - (928 - 3 * F.G)) * NWAVES + F.wave, NCW = (4 * F.G - 928) * NWAVES;
            if (cw < NWEG_P3) {
                LAS float* scr = (LAS float*)(F.lds + F.wave * 16384);
                auto dec = [&](TItem& D, const int it) __attribute__((always_inline)) { const int e = it >> 9, ii = it & 511;
                    titem_set(D, F.in[I_WEG] + (size_t)e * 1024 * 1024, 1024, (bf16_t*)(ws + WS_WGU) + (size_t)e * 2048 * 1024, 1024, 0, RM_GATE, nullptr, ii); };
                TItem Dc, Dn; float xn[32], v[32];
                dec(Dc, cw); titem_issue(Dc, xn, F.lane); titem_consume(Dc, xn, v, F.lane);
                int it = cw;
                for (; it + NCW < NWEG_P3; it += NCW) { dec(Dn, it + NCW); titem_issue(Dn, xn, F.lane); titem_body(Dc, v, scr, F.lane); titem_consume(Dn, xn, v, F.lane); Dc = Dn; }
                titem_body(Dc, v, scr, F.lane);
            }
        }
    } SEAM(3);
    if (((MK_PHASE_MASK >> 4) & 1) && IN(4)) {
        const att::Tensors T{(const bf16_t*)(ws + WS_QM), (const bf16_t*)(ws + WS_KMN), (const bf16_t*)(ws + WS_KVX), (const bf16_t*)(ws + WS_VM),
                             (const bf16_t*)(ws + WS_NQ), (const bf16_t*)(ws + WS_NK), (const bf16_t*)(ws + WS_NV), (bf16_t*)F.out, F.in[I_BIAS]};
        const int nU = (NBATCH * 8 * 16);
        if ((MK_PHASE_MASK >> 13) & 1) for (int L = F.vcu; L < nU; L += F.G) { const int xcd = (L & 255) >> 5, w = L & 31, i = L >> 8; att::attn_unit<false>(T, xcd, 2 * i + (w >> 4), w & 15, (char*)lds + RING_OFF); }
        if ((MK_PHASE_MASK >> 12) & 1) for (int L = F.vcu; L < nU; L += F.G) { const int xcd = (L & 255) >> 5, w = L & 31, i = L >> 8; att::attn_unit<true>(T, xcd, 2 * i + (w >> 4), w & 15, (char*)lds + RING_OFF); }
    } SEAM(4);
    if (((MK_PHASE_MASK >> 5) & 1) && IN(5)) {
        SchedDense S{MX / 256, 4, F.G, (int)blockIdx.x}; EpiMerge E{(bf16_t*)(ws + WS_T), (const bf16_t*)(ws + WS_GATES)};
        pg8::gemm_phase<EpiMerge, SchedDense, true>(F.lds + RING_OFF, (const bf16_t*)F.out, (const bf16_t*)(ws + WS_WPROJ), 1024, S, E);
    } SEAM(5);
    if (((MK_PHASE_MASK >> 6) & 1) && IN(6)) {
        SchedDense S{MX / 256, 4, F.G, (int)blockIdx.x}; EpiOut E{(bf16_t*)(ws + WS_MIXR)};
        pg8::gemm_phase<EpiOut, SchedDense, true>(F.lds + RING_OFF, (const bf16_t*)(ws + WS_T), (const bf16_t*)(ws + WS_WOUT), 1024, S, E);
    } SEAM(6);
    if (((MK_PHASE_MASK >> 7) & 1) && IN(7)) { p7_ln_router(F); } SEAM(7);
    if (((MK_PHASE_MASK >> 8) & 1) && IN(8)) { p8_topk_gather(F); } SEAM(8);
    if (((MK_PHASE_MASK >> 9) & 1) && IN(9)) {
        SchedExpert<8> S{F.vcu}; EpiSwiGLU E{(bf16_t*)(ws + WS_H)};
        pg8::gemm_phase<EpiSwiGLU, SchedExpert<8>, true, true>(F.lds + RING_OFF, (const bf16_t*)(ws + WS_U2), (const bf16_t*)(ws + WS_WGU), 1024, S, E, (const int*)(ws + WS_IDX));
    } SEAM(9);
    if (((MK_PHASE_MASK >> 10) & 1) && IN(10)) {
        SchedExpert<4> S{F.vcu}; EpiDown E{(bf16_t*)(ws + WS_YE), (const float*)(ws + WS_GV)};
        pg8::gemm_phase<EpiDown, SchedExpert<4>, true>(F.lds + RING_OFF, (const bf16_t*)(ws + WS_H), (const bf16_t*)(ws + WS_WD), 1024, S, E);
    } SEAM(10);
    if (((MK_PHASE_MASK >> 11) & 1) && IN(11)) { p11_final(F); }
#undef IN
#undef SEAM
}

#ifndef MK_CHECK
#define MK_CHECK 0
#endif
#if MK_CHECK
constexpr size_t WS_ERR = 900 * 1024;
constexpr size_t WS_STASH = WS_B + 100 * MiB;
__device__ __forceinline__ void err_acc(float* ERR, int stage, float num, float den) {
    __shared__ float rn[256], rd[256];
    const int tid = threadIdx.x; rn[tid] = num; rd[tid] = den; __syncthreads();
    for (int o = 128; o > 0; o >>= 1) { if (tid < o) { rn[tid] += rn[tid + o]; rd[tid] += rd[tid + o]; } __syncthreads(); }
    if (tid == 0) { atomicAdd(ERR + 2 * stage, rn[0]); atomicAdd(ERR + 2 * stage + 1, rd[0]); }
    __syncthreads();
}
#define SQ(x) ((x) * (x))
__device__ __forceinline__ float silu_ref(float v) { return v / (1.f + expf(-v)); }
__device__ __forceinline__ int sample_xrow(int i) { const int edge[8] = {0, 63, 64, 4032, 4095, 2048, 255, 256}; return (i < 64) ? ((i >> 3) * SEQ + edge[i & 7]) : (int)(((long)i * 7919 + 13) % MX); }
__device__ __forceinline__ int rope_slot(int d) { return d < 16 ? 2 * d : 2 * (d - 16) + 1; }
__device__ __forceinline__ void rope_ref(const float* in32, float* out32, int t) {
    for (int i = 0; i < 16; ++i) { const float pos = (i < 8) ? (float)(t / 64) : (float)(t % 64); const float inv = powf(10000.f, -(float)(2 * (i & 7)) / 16.f), ang = pos * inv, cs = cosf(ang), sn = sinf(ang);
        out32[i] = in32[i] * cs - in32[16 + i] * sn; out32[16 + i] = in32[i] * sn + in32[16 + i] * cs; }
}
__global__ void chk_mod(const float* c, const float* cctx, const float* wmod, const float* bmod, const float* MOD, float* ERR) {
    const int r = blockIdx.y, n = blockIdx.x * 256 + threadIdx.x; const float* cv = r < 8 ? c + r * 1024 : cctx;
    float a = bmod[n]; for (int k = 0; k < 1024; ++k) a += silu_ref(cv[k]) * wmod[(size_t)k * 6144 + n];
    err_acc(ERR, 0, SQ(MOD[r * 6144 + n] - a), SQ(a));
}
__global__ void chk_u(const float* x, const float* ctx, const float* MOD, const bf16_t* U, float* ERR) {
    const int i = blockIdx.x; const int m = (i < 16) ? ((i >> 1) * SCOMB + ((i & 1) ? 255 : 0)) : (int)(((long)i * 104729 + 7) % MC);
    const int b = m / SCOMB, j = m % SCOMB; const float* src = j < CTXL ? ctx + ((size_t)b * CTXL + j) * DM : x + ((size_t)b * SEQ + j - CTXL) * DM; const float* mr = MOD + (j < CTXL ? 8 : b) * 6144;
    __shared__ float red[256]; const int tid = threadIdx.x;
    float s = 0; for (int k = tid; k < 1024; k += 256) s += src[k]; red[tid] = s; __syncthreads(); for (int o = 128; o > 0; o >>= 1) { if (tid < o) red[tid] += red[tid + o]; __syncthreads(); } const float mean = red[0] / 1024.f; __syncthreads();
    s = 0; for (int k = tid; k < 1024; k += 256) s += SQ(src[k] - mean); red[tid] = s; __syncthreads(); for (int o = 128; o > 0; o >>= 1) { if (tid < o) red[tid] += red[tid + o]; __syncthreads(); } const float rstd = 1.f / sqrtf(red[0] / 1024.f + LN_EPS); __syncthreads();
    float num = 0, den = 0; for (int k = tid; k < 1024; k += 256) { const float y = (src[k] - mean) * rstd * (1.f + mr[1024 + k]) + mr[k]; num += SQ(bf2f(U[(size_t)m * 1024 + k]) - y); den += SQ(y); }
    err_acc(ERR, 1, num, den);
}
__global__ void chk_inproj(const bf16_t* U, const float* win, const unsigned char* ws, float* ERR) {
    const int i = blockIdx.x; const int m = (i < 16) ? ((i >> 1) * SCOMB + ((i & 1) ? 255 : 17)) : ((i < 32) ? ((i - 16) >> 1) * SCOMB + 256 + (((i & 1) ? 4095 : 64)) : (int)(((long)i * 104729 + 7) % MC));
    const int b = m / SCOMB, j = m % SCOMB, tid = threadIdx.x; const bool isx = j >= CTXL; const int t = j - CTXL; const size_t xrow = (size_t)b * SEQ + t;
    __shared__ float u[1024]; __shared__ float p[4000];
    for (int k = tid; k < 1024; k += 256) u[k] = bf2f(U[(size_t)m * 1024 + k]); __syncthreads();
    for (int n = tid; n < 4000; n += 256) { float a = 0; for (int k = 0; k < 1024; ++k) a += u[k] * win[(size_t)k * 4000 + n]; p[n] = a; } __syncthreads();
    const bf16_t *QC = (const bf16_t*)(ws + WS_QC), *KVX = (const bf16_t*)(ws + WS_KVX), *NQ = (const bf16_t*)(ws + WS_NQ), *NK = (const bf16_t*)(ws + WS_NK), *NV = (const bf16_t*)(ws + WS_NV), *GT = (const bf16_t*)(ws + WS_GATES);
    const float* ssq_kv = (const float*)(ws + WS_SSQ); const float* ssq_q = ssq_kv + MC;
    float num = 0, den = 0;
    for (int n = tid; n < 4000; n += 256) { float ref = p[n], fast; bool use = true;
        if (n < 256) { use = isx; fast = use ? bf2f(QC[xrow * 256 + n]) : 0.f; }
        else if (n < 384) fast = bf2f(KVX[(size_t)m * 256 + n - 256]);
        else if (n < 416) { const int d = n - 384; if (isx) { float o32[32]; rope_ref(p + 384, o32, t); ref = o32[d]; } fast = bf2f(KVX[(size_t)m * 256 + 128 + rope_slot(d)]); }
        else if (n < 928) { use = isx; ref *= NA_QS; fast = use ? bf2f(NQ[xrow * 512 + n - 416]) : 0.f; }
        else if (n < 1440) fast = bf2f(NK[(size_t)m * 512 + n - 928]);
        else if (n < 1952) fast = bf2f(NV[(size_t)m * 512 + n - 1440]);
        else { use = isx; ref = 1.f / (1.f + expf(-ref)); fast = use ? bf2f(GT[xrow * 2048 + n - 1952]) : 0.f; }
        if (use) { num += SQ(fast - ref); den += SQ(ref); } }
    if (tid == 0) { float s = 0; for (int n = 256; n < 384; ++n) s += SQ(p[n]); num += SQ(ssq_kv[m] - s); den += SQ(s);
        if (isx) { s = 0; for (int n = 0; n < 256; ++n) s += SQ(p[n]); num += SQ(ssq_q[xrow] - s); den += SQ(s); } }
    err_acc(ERR, 2, num, den);
}
__global__ void chk_up(const float* qg, const float* wuq, const float* kvg, const float* wukv, const unsigned char* ws, float* ERR) {
    const int i = blockIdx.x, tid = threadIdx.x; const int xr = sample_xrow(i), b = xr / SEQ, t = xr % SEQ; const size_t m = (i & 1) ? (size_t)b * SCOMB + (t & 255) : (size_t)b * SCOMB + CTXL + t;
    const bf16_t *QC = (const bf16_t*)(ws + WS_QC), *KVX = (const bf16_t*)(ws + WS_KVX), *QM = (const bf16_t*)(ws + WS_QM), *KMN = (const bf16_t*)(ws + WS_KMN), *VM = (const bf16_t*)(ws + WS_VM);
    __shared__ float qn[256], kn[128], q[768];
    { float s = 0; for (int k = 0; k < 256; ++k) s += SQ(bf2f(QC[(size_t)xr * 256 + k])); const float rs = 1.f / sqrtf(s / 256.f + RMS_EPS); qn[tid] = bf2f(QC[(size_t)xr * 256 + tid]) * rs * qg[tid]; }
    if (tid < 128) { float s = 0; for (int k = 0; k < 128; ++k) s += SQ(bf2f(KVX[m * 256 + k])); const float rs = 1.f / sqrtf(s / 128.f + RMS_EPS); kn[tid] = bf2f(KVX[m * 256 + tid]) * rs * kvg[tid]; }
    __syncthreads();
    for (int n = tid; n < 768; n += 256) { float a = 0; for (int k = 0; k < 256; ++k) a += qn[k] * wuq[(size_t)k * 768 + n]; q[n] = a; } __syncthreads();
    float num = 0, den = 0;
    for (int n = tid; n < 768; n += 256) { const int h = n / 96, d = n % 96; float ref; int col;
        if (d < 64) { ref = q[n]; col = n; } else { float o32[32]; rope_ref(q + h * 96 + 64, o32, t); ref = o32[d - 64]; col = h * 96 + 64 + rope_slot(d - 64); }
        ref *= MLA_QS; const float fast = bf2f(QM[(size_t)xr * 768 + col]); num += SQ(fast - ref); den += SQ(ref); }
    for (int n = tid; n < 1024; n += 256) { float a = 0; for (int k = 0; k < 128; ++k) a += kn[k] * wukv[(size_t)k * 1024 + n]; const int h = n >> 7, d = n & 127;
        const float fast = d < 64 ? bf2f(KMN[m * 512 + h * 64 + d]) : bf2f(VM[m * 512 + h * 64 + d - 64]); num += SQ(fast - a); den += SQ(a); }
    err_acc(ERR, 3, num, den);
}
__global__ void chk_attn(const float* rel_bias, const unsigned char* ws, const bf16_t* Y, float* ERR) {
    const int pr[12] = {0, 0, 63, 63, 3, 4, 31, 59, 60, 5, 32, 17}, pc[12] = {0, 63, 0, 63, 7, 8, 31, 55, 56, 40, 3, 60};
    const int si = blockIdx.x, h = blockIdx.y, kind = blockIdx.z, b = si / 12, r = pr[si % 12], c = pc[si % 12], t = r * 64 + c, tid = threadIdx.x;
    const size_t xr = (size_t)b * SEQ + t, kb = (size_t)b * SCOMB;
    const bf16_t *QM = (const bf16_t*)(ws + WS_QM), *KMN = (const bf16_t*)(ws + WS_KMN), *KVX = (const bf16_t*)(ws + WS_KVX), *VM = (const bf16_t*)(ws + WS_VM), *NQ = (const bf16_t*)(ws + WS_NQ), *NK = (const bf16_t*)(ws + WS_NK), *NV = (const bf16_t*)(ws + WS_NV);
    __shared__ float sc[SCOMB]; __shared__ int krow[SCOMB]; __shared__ float red[256]; __shared__ float ov[4][64];
    int nk;
    if (kind == 0) { nk = SCOMB; for (int k = tid; k < nk; k += 256) { float a = 0; for (int d = 0; d < 64; ++d) a += bf2f(QM[xr * 768 + h * 96 + d]) * bf2f(KMN[(kb + k) * 512 + h * 64 + d]);
            for (int d = 0; d < 32; ++d) a += bf2f(QM[xr * 768 + h * 96 + 64 + d]) * bf2f(KVX[(kb + k) * 256 + 128 + d]); sc[k] = a; krow[k] = k; } }
    else { nk = 384; const int r0 = min(max(r - 4, 0), 56), c0 = min(max(c - 8, 0), 48);
        for (int k = tid; k < nk; k += 256) { int row; float bias = 0.f; if (k < 256) row = k; else { const int w = k - 256, rr = r0 + (w >> 4), kc = c0 + (w & 15); row = 256 + rr * 64 + kc; bias = rel_bias[(h * 15 + rr - r + 7) * 31 + kc - c + 15] * LOG2E; }
            float a = 0; for (int d = 0; d < 64; ++d) a += bf2f(NQ[xr * 512 + h * 64 + d]) * bf2f(NK[(kb + row) * 512 + h * 64 + d]); sc[k] = a + bias; krow[k] = row; } }
    __syncthreads();
    float mx = -1e30f; for (int k = tid; k < nk; k += 256) mx = fmaxf(mx, sc[k]); red[tid] = mx; __syncthreads(); for (int o = 128; o > 0; o >>= 1) { if (tid < o) red[tid] = fmaxf(red[tid], red[tid + o]); __syncthreads(); } mx = red[0]; __syncthreads();
    float sm = 0; for (int k = tid; k < nk; k += 256) { const float p = exp2f(sc[k] - mx); sc[k] = p; sm += p; } red[tid] = sm; __syncthreads(); for (int o = 128; o > 0; o >>= 1) { if (tid < o) red[tid] += red[tid + o]; __syncthreads(); } sm = red[0]; __syncthreads();
    const bf16_t* V = kind == 0 ? VM : NV; const int d = tid & 63, part = tid >> 6; float a = 0; for (int k = part; k < nk; k += 4) a += sc[k] * bf2f(V[(kb + krow[k]) * 512 + h * 64 + d]); ov[part][d] = a; __syncthreads();
    float num = 0, den = 0; if (tid < 64) { const float ref = (ov[0][tid] + ov[1][tid] + ov[2][tid] + ov[3][tid]) / sm; const float fast = bf2f(Y[xr * 1024 + kind * 512 + h * 64 + tid]); num = SQ(fast - ref); den = SQ(ref); }
    err_acc(ERR, 4 + kind * 8, num, den);
}
#define ROWDOT(acc, xin, K, W, ldw, n) do { acc = 0.f; for (int k_ = 0; k_ < (K); ++k_) acc += (xin)[k_] * (W)[(size_t)k_ * (ldw) + (n)]; } while (0)
__global__ void chk_merge(const float* wpm, const float* wpn, const unsigned char* ws, const bf16_t* Y, float* ERR) {
    const int xr = sample_xrow(blockIdx.x), tid = threadIdx.x; const bf16_t *GT = (const bf16_t*)(ws + WS_GATES), *T = (const bf16_t*)(ws + WS_T);
    __shared__ float y[1024]; for (int k = tid; k < 1024; k += 256) y[k] = bf2f(Y[(size_t)xr * 1024 + k]); __syncthreads();
    float num = 0, den = 0;
    for (int n = tid; n < 1024; n += 256) { float a, c; ROWDOT(a, y, 512, wpm, 1024, n); ROWDOT(c, y + 512, 512, wpn, 1024, n);
        const float ref = bf2f(GT[(size_t)xr * 2048 + n]) * a + bf2f(GT[(size_t)xr * 2048 + 1024 + n]) * c; num += SQ(bf2f(T[(size_t)xr * 1024 + n]) - ref); den += SQ(ref); }
    err_acc(ERR, 5, num, den);
}
__global__ void chk_out(const float* x, const float* wout, const float* MOD, const float* ln1g, const float* ln1b, const float* wr, const unsigned char* ws, const float* V, float* stash, float* ERR) {
    const int xr = sample_xrow(blockIdx.x), b = xr / SEQ, tid = threadIdx.x; const bf16_t* T = (const bf16_t*)(ws + WS_T); const bf16_t* MR = (const bf16_t*)(ws + WS_MIXR);
    __shared__ float tv[1024], x1[1024], u2[1024], red[256], vv[1024]; for (int k = tid; k < 1024; k += 256) tv[k] = bf2f(T[(size_t)xr * 1024 + k]); __syncthreads();
    float num = 0, den = 0;
    for (int n = tid; n < 1024; n += 256) { float a; ROWDOT(a, tv, 1024, wout, 1024, n); const float fast = bf2f(MR[(size_t)xr * 1024 + n]); num += SQ(fast - a); den += SQ(a); }
    err_acc(ERR, 6, num, den);
    for (int k = tid; k < 1024; k += 256) vv[k] = ALPHA * x[(size_t)xr * 1024 + k] + MOD[b * 6144 + 2048 + k] * bf2f(MR[(size_t)xr * 1024 + k]); __syncthreads();
    float s = 0; for (int k = tid; k < 1024; k += 256) s += vv[k]; red[tid] = s; __syncthreads(); for (int o = 128; o > 0; o >>= 1) { if (tid < o) red[tid] += red[tid + o]; __syncthreads(); } float mean = red[0] / 1024.f; __syncthreads();
    s = 0; for (int k = tid; k < 1024; k += 256) s += SQ(vv[k] - mean); red[tid] = s; __syncthreads(); for (int o = 128; o > 0; o >>= 1) { if (tid < o) red[tid] += red[tid + o]; __syncthreads(); } float rstd = 1.f / sqrtf(red[0] / 1024.f + LN_EPS); __syncthreads();
    for (int k = tid; k < 1024; k += 256) x1[k] = (vv[k] - mean) * rstd * ln1g[k] + ln1b[k]; __syncthreads();
    s = 0; for (int k = tid; k < 1024; k += 256) s += x1[k]; red[tid] = s; __syncthreads(); for (int o = 128; o > 0; o >>= 1) { if (tid < o) red[tid] += red[tid + o]; __syncthreads(); } mean = red[0] / 1024.f; __syncthreads();
    s = 0; for (int k = tid; k < 1024; k += 256) s += SQ(x1[k] - mean); red[tid] = s; __syncthreads(); for (int o = 128; o > 0; o >>= 1) { if (tid < o) red[tid] += red[tid + o]; __syncthreads(); } rstd = 1.f / sqrtf(red[0] / 1024.f + LN_EPS); __syncthreads();
    for (int k = tid; k < 1024; k += 256) u2[k] = (x1[k] - mean) * rstd * (1.f + MOD[b * 6144 + 4096 + k]) + MOD[b * 6144 + 3072 + k]; __syncthreads();
    float* st = stash + (size_t)blockIdx.x * 2304;
    for (int k = tid; k < 1024; k += 256) { st[k] = x1[k]; st[1024 + k] = u2[k]; }
    if (tid < 16) { float a; ROWDOT(a, u2, 1024, wr, 16, tid); red[tid] = a; } __syncthreads();
    if (tid < 16) { float mx = -1e30f; for (int e = 0; e < 16; ++e) mx = fmaxf(mx, red[e]); float sm = 0; for (int e = 0; e < 16; ++e) sm += expf(red[e] - mx); st[2048 + tid] = expf(red[tid] - mx) / sm; }
}
__global__ void chk_p7(const unsigned char* ws, const float*  , const float* stash, float* ERR) {
    const int xr = sample_xrow(blockIdx.x), tid = threadIdx.x; const float* st = stash + (size_t)blockIdx.x * 2304; const bf16_t* U2 = (const bf16_t*)(ws + WS_U2); const float* AFF = (const float*)(ws + WS_AFF);
    float num = 0, den = 0;
    for (int k = tid; k < 1024; k += 256) { num += SQ(bf2f(U2[(size_t)xr * 1024 + k]) - st[1024 + k]); den += SQ(st[1024 + k]); }
    err_acc(ERR, 7, num, den);
    num = 0; den = 0; if (tid < 16) { num = SQ(AFF[(size_t)xr * 16 + tid] - st[2048 + tid]); den = SQ(st[2048 + tid]); }
    err_acc(ERR, 13, num, den);
}
__global__ void chk_topk(const unsigned char* ws, float* ERR) {
    const int tk = blockIdx.x, e = tk >> 3, b = tk & 7, tid = threadIdx.x; const float* AFF = (const float*)(ws + WS_AFF); const int* INV = (const int*)(ws + WS_INV); const float* GV = (const float*)(ws + WS_GV);
    const int* IDX = (const int*)(ws + WS_IDX);
    __shared__ float rmin[256], rmax[256]; __shared__ int rc[256];
    float mn = 1e30f, mx = -1e30f; int cnt = 0; float bad = 0;
    for (int t = tid; t < SEQ; t += 256) { const int sl = INV[((size_t)b * SEQ + t) * 16 + e]; const float a = AFF[((size_t)b * SEQ + t) * 16 + e];
        if (sl >= 0) { mn = fminf(mn, a); ++cnt; if (sl >= CAP) bad += 1; else { if (GV[(size_t)tk * CAP + sl] != a) bad += 1; if (IDX[(size_t)tk * CAP + sl] != b * SEQ + t) bad += 1; } }
        else mx = fmaxf(mx, a); }
    rmin[tid] = mn; rmax[tid] = mx; rc[tid] = cnt; __syncthreads();
    for (int o = 128; o > 0; o >>= 1) { if (tid < o) { rmin[tid] = fminf(rmin[tid], rmin[tid + o]); rmax[tid] = fmaxf(rmax[tid], rmax[tid + o]); rc[tid] += rc[tid + o]; } __syncthreads(); }
    if (tid == 0) { if (rc[0] != CAP) bad += 100; if (rmin[0] < rmax[0]) bad += 100; }
    err_acc(ERR, 8, bad, tid == 0 ? 1.f / 128.f : 0.f);
}
__global__ void chk_exp_up(const float* weg, const float* weu, const unsigned char* ws, float* ERR) {
    const int row = (int)(((long)blockIdx.x * 104729 + 511) % ME), e = row / (CAP * 8), tid = threadIdx.x; const bf16_t *U2 = (const bf16_t*)(ws + WS_U2), *H = (const bf16_t*)(ws + WS_H); const int* IDX = (const int*)(ws + WS_IDX);
    __shared__ float xe[1024]; for (int k = tid; k < 1024; k += 256) xe[k] = bf2f(U2[(size_t)IDX[row] * 1024 + k]); __syncthreads();
    float num = 0, den = 0; const float* wg = weg + (size_t)e * 1024 * 1024; const float* wu = weu + (size_t)e * 1024 * 1024;
    for (int n = tid; n < 1024; n += 256) { float g, u; ROWDOT(g, xe, 1024, wg, 1024, n); ROWDOT(u, xe, 1024, wu, 1024, n); const float ref = silu_ref(g) * u; num += SQ(bf2f(H[(size_t)row * 1024 + n]) - ref); den += SQ(ref); }
    err_acc(ERR, 9, num, den);
}
__global__ void chk_exp_down(const float* wed, const unsigned char* ws, float* ERR) {
    const int row = (int)(((long)blockIdx.x * 104729 + 511) % ME), e = row / (CAP * 8), tid = threadIdx.x; const bf16_t *H = (const bf16_t*)(ws + WS_H), *YE = (const bf16_t*)(ws + WS_YE); const float* GV = (const float*)(ws + WS_GV);
    __shared__ float hv[1024]; for (int k = tid; k < 1024; k += 256) hv[k] = bf2f(H[(size_t)row * 1024 + k]); __syncthreads();
    float num = 0, den = 0; const float* wd = wed + (size_t)e * 1024 * 1024;
    for (int n = tid; n < 1024; n += 256) { float a; ROWDOT(a, hv, 1024, wd, 1024, n); const float ref = a * GV[row]; num += SQ(bf2f(YE[(size_t)row * 1024 + n]) - ref); den += SQ(ref); }
    err_acc(ERR, 10, num, den);
}
__global__ void chk_final_pre(const float* MOD, const float* ln2g, const float* ln2b, const unsigned char* ws, const float* x, const float* ln1g, const float* ln1b, float* stash) {
    const int xr = sample_xrow(blockIdx.x), b = xr / SEQ, t = xr % SEQ, tid = threadIdx.x; const bf16_t* YE = (const bf16_t*)(ws + WS_YE); const int* INV = (const int*)(ws + WS_INV); const bf16_t* MR = (const bf16_t*)(ws + WS_MIXR);
    __shared__ float v[1024], red[256];
    for (int k = tid; k < 1024; k += 256) v[k] = ALPHA * x[(size_t)xr * 1024 + k] + MOD[b * 6144 + 2048 + k] * bf2f(MR[(size_t)xr * 1024 + k]); __syncthreads();
    float s = 0; for (int k = tid; k < 1024; k += 256) s += v[k]; red[tid] = s; __syncthreads(); for (int o = 128; o > 0; o >>= 1) { if (tid < o) red[tid] += red[tid + o]; __syncthreads(); } float mean = red[0] / 1024.f; __syncthreads();
    s = 0; for (int k = tid; k < 1024; k += 256) s += SQ(v[k] - mean); red[tid] = s; __syncthreads(); for (int o = 128; o > 0; o >>= 1) { if (tid < o) red[tid] += red[tid + o]; __syncthreads(); } float rstd = 1.f / sqrtf(red[0] / 1024.f + LN_EPS); __syncthreads();
    for (int k = tid; k < 1024; k += 256) { const float x1 = (v[k] - mean) * rstd * ln1g[k] + ln1b[k]; float mo = 0; for (int e = 0; e < 16; ++e) { const int sl = INV[((size_t)b * SEQ + t) * 16 + e]; if (sl >= 0) mo += bf2f(YE[((size_t)(e * 8 + b) * CAP + sl) * 1024 + k]); }
        v[k] = ALPHA * x1 + MOD[b * 6144 + 5120 + k] * mo; } __syncthreads();
    s = 0; for (int k = tid; k < 1024; k += 256) s += v[k]; red[tid] = s; __syncthreads(); for (int o = 128; o > 0; o >>= 1) { if (tid < o) red[tid] += red[tid + o]; __syncthreads(); } mean = red[0] / 1024.f; __syncthreads();
    s = 0; for (int k = tid; k < 1024; k += 256) s += SQ(v[k] - mean); red[tid] = s; __syncthreads(); for (int o = 128; o > 0; o >>= 1) { if (tid < o) red[tid] += red[tid + o]; __syncthreads(); } rstd = 1.f / sqrtf(red[0] / 1024.f + LN_EPS);
    for (int k = tid; k < 1024; k += 256) stash[(size_t)blockIdx.x * 1024 + k] = (v[k] - mean) * rstd * ln2g[k] + ln2b[k];
}
__global__ void chk_final_post(const float* out, const float* stash, float* ERR) {
    const int xr = sample_xrow(blockIdx.x), tid = threadIdx.x; float num = 0, den = 0;
    for (int k = tid; k < 1024; k += 256) { num += SQ(out[(size_t)xr * 1024 + k] - stash[(size_t)blockIdx.x * 1024 + k]); den += SQ(stash[(size_t)blockIdx.x * 1024 + k]); }
    err_acc(ERR, 11, num, den);
}
__global__ void chk_scale(float* out, const float* ERR, unsigned mask, float gain) {
    float e = 0; for (int p = 0; p < 16; ++p) if ((mask >> p) & 1u) e += ERR[2 * p] / fmaxf(ERR[2 * p + 1], 1e-30f);
    const float f = 1.f + sqrtf(e * gain);
    for (size_t i = (size_t)blockIdx.x * 256 + threadIdx.x; i < (size_t)MX * DM; i += (size_t)gridDim.x * 256) out[i] *= f;
}
#endif

extern "C" void kernel_launch(void* const* d_in, const int* in_sizes, int n_in, void* d_out, int out_size, void* d_ws, size_t ws_size, hipStream_t stream) {
    static int grid = 0;
    if (grid == 0) {
        if (n_in != 23 || in_sizes[0] != MX * DM || out_size != MX * DM || ws_size < WS_END) {
            fprintf(stderr, "kernel_launch: shape mismatch: n_in %d in0 %d out %d ws %zu (need >= %zu)\n", n_in, n_in > 0 ? in_sizes[0] : -1, out_size, ws_size, (size_t)WS_END); grid = -1; return; }
        int dev = 0, cus = 0, per_cu = 0;
        if (hipGetDevice(&dev) != hipSuccess || hipDeviceGetAttribute(&cus, hipDeviceAttributeMultiprocessorCount, dev) != hipSuccess) { fprintf(stderr, "kernel_launch: device query failed\n"); grid = -1; return; }
        if (hipFuncSetAttribute((const void*)fwd_mega, hipFuncAttributeMaxDynamicSharedMemorySize, LDS_BYTES) != hipSuccess) { fprintf(stderr, "kernel_launch: hipFuncSetAttribute failed\n"); grid = -1; return; }
        if (hipOccupancyMaxActiveBlocksPerMultiprocessor(&per_cu, (const void*)fwd_mega, NWAVES * 64, LDS_BYTES) != hipSuccess || per_cu < 1) { fprintf(stderr, "kernel_launch: occupancy query reports %d blocks per CU\n", per_cu); (void)hipGetLastError(); grid = -1; return; }
        grid = cus;
        if (grid != 256) { fprintf(stderr, "kernel_launch: this kernel's unit orders are built for 256 CUs, found %d\n", cus); grid = -1; return; }
    }
    if (grid < 0) return;
    (void)hipMemsetAsync((char*)d_ws + WS_CTL, 0, CTL_ZERO_BYTES, stream);
    Args a{};
    for (int i = 0; i < 23; ++i) a.in[i] = (const float*)d_in[i];
    a.out = (float*)d_out; a.ws = (unsigned char*)d_ws;
#if MK_CHECK
    {
        const unsigned char* ws = (const unsigned char*)d_ws; float* ERR = (float*)((char*)d_ws + WS_ERR); const float* MOD = (const float*)((char*)d_ws + WS_MOD);
        float* stash = (float*)((char*)d_ws + WS_STASH); float* stash2 = (float*)((char*)d_ws + WS_C + 64 * MiB); const float* const* in = (const float* const*)a.in; float* out = (float*)d_out;
        constexpr int NS = 192;
        for (int p = 0; p < N_PHASES; ++p) {
            if (p == 11) chk_final_pre<<<NS, 256, 0, stream>>>(MOD, in[I_LN2G], in[I_LN2B], ws, in[I_X], in[I_LN1G], in[I_LN1B], stash2);
            a.ph_lo = p; a.ph_hi = p + 1; hipLaunchKernelGGL(fwd_mega, dim3(grid), dim3(NWAVES * 64), LDS_BYTES, stream, a);
            switch (p) {
            case 0: chk_mod<<<dim3(24, 9), 256, 0, stream>>>(in[I_C], in[I_CCTX], in[I_WMOD], in[I_BMOD], MOD, ERR); break;
            case 1: chk_u<<<NS, 256, 0, stream>>>(in[I_X], in[I_CTX], MOD, (const bf16_t*)(ws + WS_U), ERR); break;
            case 2: chk_inproj<<<96, 256, 0, stream>>>((const bf16_t*)(ws + WS_U), in[I_WIN], ws, ERR); break;
            case 3: chk_up<<<NS, 256, 0, stream>>>(in[I_QG], in[I_WUQ], in[I_KVG], in[I_WUKV], ws, ERR); break;
            case 4: chk_attn<<<dim3(96, 8, 2), 256, 0, stream>>>(in[I_BIAS], ws, (const bf16_t*)out, ERR); break;
            case 5: chk_merge<<<NS, 256, 0, stream>>>(in[I_WPM], in[I_WPN], ws, (const bf16_t*)out, ERR); break;
            case 6: chk_out<<<NS, 256, 0, stream>>>(in[I_X], in[I_WOUT], MOD, in[I_LN1G], in[I_LN1B], in[I_WR], ws, out, stash, ERR); break;
            case 7: chk_p7<<<NS, 256, 0, stream>>>(ws, out, stash, ERR); break;
            case 8: chk_topk<<<128, 256, 0, stream>>>(ws, ERR); break;
            case 9: chk_exp_up<<<NS, 256, 0, stream>>>(in[I_WEG], in[I_WEU], ws, ERR); break;
            case 10: chk_exp_down<<<NS, 256, 0, stream>>>(in[I_WED], ws, ERR); break;
            case 11: chk_final_post<<<NS, 256, 0, stream>>>(out, stash2, ERR); break;
            }
        }
        chk_scale<<<1024, 256, 0, stream>>>(out, ERR, (unsigned)(MK_CHECK), 1.0f);
    }
#elif MK_N_LAUNCHES == 1
    a.ph_lo = 0; a.ph_hi = N_PHASES;
    void* kargs[] = {&a};
    hipError_t le = hipLaunchCooperativeKernel((const void*)fwd_mega, dim3(grid), dim3(NWAVES * 64), kargs, LDS_BYTES, stream);
    if (le != hipSuccess) fprintf(stderr, "kernel_launch: cooperative launch failed: %s\n", hipGetErrorName(le));
#else
    for (int p = 0; p < N_PHASES; ++p) for (int r = 0; r < 1 + ((MK_REPEAT >> p) & 1); ++r) { a.ph_lo = p; a.ph_hi = p + 1; a.rep = r; hipLaunchKernelGGL(fwd_mega, dim3(grid), dim3(NWAVES * 64), LDS_BYTES, stream, a); }
#endif
}
```
